# Optimizing an MI355X kernel written in HIP

```python
import jax, jax.numpy as jnp
from jax import lax
import numpy as np

D_MODEL = 1024
BATCH = 4
SEQ = 4096
DEPTH = 4

CHUNK = 64
N_MIXERS = 2
HEAD_SIZE = 64
N_HEADS = D_MODEL // HEAD_SIZE
D_FF = 4 * D_MODEL
CONV_WIDTH = 3
D_DECAY_LORA = 64
D_AAA_LORA = 64
D_MV_LORA = 32
D_GATE_LORA = 160
N_CONV_LAYERS = (DEPTH + 1) // 2
N_RWKV_LAYERS = DEPTH // 2
N_VRES = max(N_RWKV_LAYERS - 1, 0)
N_MOD = 6
NORM_EPS = 1e-6
GN_EPS = 64e-5

kernel_name = "hybrid_shortconv_rwkv7_adaln_encoder"


def _rmsnorm(x, g):
    x32 = x.astype(jnp.float32)
    y = x32 * lax.rsqrt(jnp.mean(x32 * x32, axis=-1, keepdims=True) + NORM_EPS)
    return (y * g.astype(jnp.float32)).astype(x.dtype)


def _modulate(h, shift, scale):
    return h * (1 + scale[:, None, :]) + shift[:, None, :]


def _short_conv_mixer(h, w_in, conv_w, w_out):
    bch = h @ w_in
    b_gate, c_gate, hv = jnp.split(bch, 3, axis=-1)
    u = c_gate * hv
    conv = lax.conv_general_dilated(
        u, conv_w[:, None, :], window_strides=(1,),
        padding=[(CONV_WIDTH - 1, 0)],
        dimension_numbers=('NWC', 'WIO', 'NWC'),
        feature_group_count=D_MODEL)
    return (b_gate * conv) @ w_out


def _wkv7_scan(r, w, k, v, a, b):
    bsz, seq = r.shape[0], r.shape[1]

    def to_chunks(t):
        return t.transpose(1, 0, 2, 3).reshape(seq // CHUNK, CHUNK, bsz, N_HEADS, HEAD_SIZE)

    def frame_step(state, inp):
        r_t, w_t, k_t, v_t, a_t, b_t = inp
        sa = jnp.einsum('bhvk,bhk->bhv', state, a_t)
        state = (state * w_t[:, :, None, :]
                 + sa[..., None] * b_t[:, :, None, :]
                 + v_t[..., None] * k_t[:, :, None, :])
        y_t = jnp.einsum('bhvk,bhk->bhv', state, r_t)
        return state, y_t

    def chunk_step(state, inp_chunk):
        return lax.scan(frame_step, state, inp_chunk)

    s0 = jnp.zeros((bsz, N_HEADS, HEAD_SIZE, HEAD_SIZE), jnp.float32)
    inputs = (to_chunks(r), to_chunks(w), to_chunks(k), to_chunks(v), to_chunks(a), to_chunks(b))
    _, y = lax.scan(chunk_step, s0, inputs)
    return y.reshape(seq, bsz, N_HEADS, HEAD_SIZE).transpose(1, 0, 2, 3)


def _rwkv7_mixer(h, v_first, vres, mu, w_rkv, w_o, w0, w1, w2, a0, a1, a2,
                 g1, g2, k_k, k_a, r_k, ln_w, ln_b):
    bsz, seq, d = h.shape
    h_prev = jnp.pad(h, ((0, 0), (1, 0), (0, 0)))[:, :-1]
    xx = h_prev - h
    xr, xw, xk, xv, xa, xg = h[None] + xx[None] * mu[:, None, None, :]
    r, k, v = jnp.einsum('nbsd,nde->nbse', jnp.stack([xr, xk, xv]), w_rkv)
    w = -jax.nn.softplus(-(w0 + jnp.tanh(xw @ w1) @ w2)) - 0.5
    a = jax.nn.sigmoid(a0 + (xa @ a1) @ a2)
    g = jax.nn.sigmoid(xg @ g1) @ g2
    if vres is None:
        v_first = v
    else:
        v0, v1, v2 = vres
        v = v + (v_first - v) * jax.nn.sigmoid(v0 + (xv @ v1) @ v2)

    def heads(t):
        return t.reshape(bsz, seq, N_HEADS, HEAD_SIZE).astype(jnp.float32)

    kk = heads(k * k_k)
    kk = kk / jnp.maximum(jnp.sqrt(jnp.sum(kk * kk, axis=-1, keepdims=True)), 1e-12)
    k = k * (1 + (a - 1) * k_a)
    rh, kh, vh, ah = heads(r), heads(k), heads(v), heads(a)
    decay = jnp.exp(-jnp.exp(heads(w)))
    y = _wkv7_scan(rh, decay, kh, vh, -kk, kk * ah)
    mean = jnp.mean(y, axis=-1, keepdims=True)
    var = jnp.mean(jnp.square(y - mean), axis=-1, keepdims=True)
    y = (y - mean) * lax.rsqrt(var + GN_EPS)
    y = y * ln_w.reshape(N_HEADS, HEAD_SIZE) + ln_b.reshape(N_HEADS, HEAD_SIZE)
    bonus = jnp.sum(rh * kh * r_k, axis=-1, keepdims=True) * vh
    out = ((y + bonus).reshape(bsz, seq, d).astype(h.dtype) * g) @ w_o
    return out, v_first


def setup_inputs(seed: int = 0) -> dict:
    key = jax.random.key(seed)
    ks = iter(jax.random.split(key, 40))
    D = D_MODEL
    nrm = lambda shape, s: jax.random.normal(next(ks), shape, jnp.float32) * s
    uni = lambda shape, lo, hi: jax.random.uniform(next(ks), shape, jnp.float32, lo, hi)
    NC, NR, NV = N_CONV_LAYERS, N_RWKV_LAYERS, N_VRES
    return {
        "x": nrm((BATCH, SEQ, D), 1.0),
        "c": nrm((BATCH, D), 1.0),
        "norm_g": 1.0 + nrm((DEPTH, 2, D), 0.05),
        "final_g": 1.0 + nrm((D,), 0.05),
        "ada_w": nrm((DEPTH, D, N_MOD * D), 0.5 * D ** -0.5),
        "ada_b": nrm((DEPTH, N_MOD * D), 0.02),
        "conv_w_in": nrm((NC, D, 3 * D), D ** -0.5),
        "conv_w": nrm((NC, CONV_WIDTH, D), CONV_WIDTH ** -0.5),
        "conv_w_out": nrm((NC, D, D), D ** -0.5),
        "rw_mu": uni((NR, 6, D), 0.0, 1.0),
        "rw_w_rkv": nrm((NR, 3, D, D), D ** -0.5),
        "rw_w_o": nrm((NR, D, D), D ** -0.5),
        "rw_w0": uni((NR, D), -6.5, -1.5),
        "rw_w1": nrm((NR, D, D_DECAY_LORA), D ** -0.5),
        "rw_w2": nrm((NR, D_DECAY_LORA, D), 0.1 * D_DECAY_LORA ** -0.5),
        "rw_a0": nrm((NR, D), 0.1),
        "rw_a1": nrm((NR, D, D_AAA_LORA), D ** -0.5),
        "rw_a2": nrm((NR, D_AAA_LORA, D), 0.1 * D_AAA_LORA ** -0.5),
        "rw_g1": nrm((NR, D, D_GATE_LORA), D ** -0.5),
        "rw_g2": nrm((NR, D_GATE_LORA, D), D_GATE_LORA ** -0.5),
        "rw_k_k": 0.85 + nrm((NR, D), 0.05),
        "rw_k_a": 1.0 + nrm((NR, D), 0.05),
        "rw_r_k": nrm((NR, N_HEADS, HEAD_SIZE), 0.1),
        "rw_ln_w": 1.0 + nrm((NR, D), 0.05),
        "rw_ln_b": nrm((NR, D), 0.02),
        "rw_v0": 1.0 + nrm((NV, D), 0.1),
        "rw_v1": nrm((NV, D, D_MV_LORA), D ** -0.5),
        "rw_v2": nrm((NV, D_MV_LORA, D), 0.1 * D_MV_LORA ** -0.5),
        "mlp_w1": nrm((DEPTH, D, D_FF), D ** -0.5),
        "mlp_w2": nrm((DEPTH, D_FF, D), D_FF ** -0.5),
    }


def reference(x, c, norm_g, final_g, ada_w, ada_b, conv_w_in, conv_w, conv_w_out,
              rw_mu, rw_w_rkv, rw_w_o, rw_w0, rw_w1, rw_w2, rw_a0, rw_a1, rw_a2,
              rw_g1, rw_g2, rw_k_k, rw_k_a, rw_r_k, rw_ln_w, rw_ln_b,
              rw_v0, rw_v1, rw_v2, mlp_w1, mlp_w2):
    c_act = jax.nn.silu(c)
    v_first = None
    for i in range(DEPTH):
        mod = c_act @ ada_w[i] + ada_b[i]
        sh1, sc1, gt1, sh2, sc2, gt2 = jnp.split(mod, N_MOD, axis=-1)
        h = _modulate(_rmsnorm(x, norm_g[i, 0]), sh1, sc1)
        j = i // N_MIXERS
        if i % N_MIXERS == 0:
            y = _short_conv_mixer(h, conv_w_in[j], conv_w[j], conv_w_out[j])
        else:
            vres = None if v_first is None else (rw_v0[j - 1], rw_v1[j - 1], rw_v2[j - 1])
            y, v_first = _rwkv7_mixer(
                h, v_first, vres, rw_mu[j], rw_w_rkv[j], rw_w_o[j], rw_w0[j], rw_w1[j],
                rw_w2[j], rw_a0[j], rw_a1[j], rw_a2[j], rw_g1[j], rw_g2[j], rw_k_k[j],
                rw_k_a[j], rw_r_k[j], rw_ln_w[j], rw_ln_b[j])
        x = x + gt1[:, None, :] * y
        h = _modulate(_rmsnorm(x, norm_g[i, 1]), sh2, sc2)
        x = x + gt2[:, None, :] * (jnp.square(jax.nn.relu(h @ mlp_w1[i])) @ mlp_w2[i])
    return _rmsnorm(x, final_g)
```

```cpp
#include <hip/hip_runtime.h>
#include <hip/hip_cooperative_groups.h>
#include <cstdio>
namespace cg = cooperative_groups;

#define LAS __attribute__((address_space(3)))
typedef unsigned short bf16_t;
typedef short bf16x8 __attribute__((ext_vector_type(8)));
typedef float f32x4 __attribute__((ext_vector_type(4)));
typedef float f32x2 __attribute__((ext_vector_type(2)));
typedef unsigned u32x4 __attribute__((ext_vector_type(4)));
typedef unsigned u32x2 __attribute__((ext_vector_type(2)));

constexpr int D = 1024, NB = 4, SEQ = 4096, M = NB * SEQ, FF = 4096, NMOD = 6 * D;
constexpr int PADROWS = 256, HROWS = SEQ + PADROWS;
constexpr int NTHREADS = 512;
constexpr int LDS_BAR_OFF = 140800;
constexpr int LDS_BYTES = LDS_BAR_OFF + 256;

constexpr size_t MBy = 1u << 20;
constexpr size_t WS_MOD = 0;
constexpr size_t WS_BR = 512 * 1024;
constexpr size_t WS_RK = WS_BR + MBy;
constexpr size_t WS_BAR = 3 * MBy;
constexpr size_t WS_GG = 3 * MBy + 64 * 1024;
constexpr size_t WS_SHW1 = 3 * MBy + 256 * 1024;
constexpr size_t WS_SHWIN = 3 * MBy + 512 * 1024;
constexpr size_t WS_W1T = 4 * MBy;
constexpr size_t WS_W2T = 36 * MBy;
constexpr size_t WS_WINT = 68 * MBy;
constexpr size_t WS_WOUTT = 80 * MBy;
constexpr size_t WS_RKVT = 84 * MBy;
constexpr size_t WS_WOT = 96 * MBy;
constexpr size_t WS_L1T = 100 * MBy;
constexpr size_t WS_L2T = 104 * MBy;
constexpr size_t WS_HB = 108 * MBy;
constexpr size_t WS_MIDS = 142 * MBy;
constexpr size_t WS_VF = 158 * MBy;
constexpr size_t WS_R0 = 190 * MBy;
constexpr size_t WS_SS = 382 * MBy;
constexpr size_t WS_END = 383 * MBy;
constexpr int LDS_RINV_OFF = 131072;

struct Params { const float* in[30]; float* out; unsigned char* ws; };

typedef __bf16 bf16v2_t __attribute__((ext_vector_type(2)));
__device__ __forceinline__ unsigned cvt_pk_bf16(float lo, float hi) { const f32x2 v = (f32x2){lo, hi}; return __builtin_bit_cast(unsigned, __builtin_convertvector(v, bf16v2_t)); }
typedef _Float16 f16v2_t __attribute__((ext_vector_type(2)));
typedef _Float16 f16x8 __attribute__((ext_vector_type(8)));
__device__ __forceinline__ unsigned cvt_pk_f16(float lo, float hi) { const f32x2 v = (f32x2){lo, hi}; return __builtin_bit_cast(unsigned, __builtin_convertvector(v, f16v2_t)); }
__device__ __forceinline__ f32x2 unpk_f16(unsigned w) { return __builtin_convertvector(__builtin_bit_cast(f16v2_t, w), f32x2); }
__device__ __forceinline__ float bflo(unsigned v) { return __uint_as_float(v << 16); }
__device__ __forceinline__ float bfhi(unsigned v) { return __uint_as_float(v & 0xffff0000u); }
__device__ __forceinline__ float rbf(float x) { unsigned u = __float_as_uint(x); u += 0x7FFFu + ((u >> 16) & 1u); return __uint_as_float(u & 0xffff0000u); }
__device__ __forceinline__ f32x4 ld_bf4(const bf16_t* p) { const u32x2 v = *(const u32x2*)p; return (f32x4){bflo(v.x), bfhi(v.x), bflo(v.y), bfhi(v.y)}; }
__device__ __forceinline__ f32x4 ld_h4(const bf16_t* p) { const u32x2 v = *(const u32x2*)p; const f32x2 a = unpk_f16(v.x), b = unpk_f16(v.y); return (f32x4){a.x, a.y, b.x, b.y}; }
__device__ __forceinline__ void st_h4(bf16_t* p, f32x4 v) { u32x2 o; o.x = cvt_pk_f16(v[0], v[1]); o.y = cvt_pk_f16(v[2], v[3]); *(u32x2*)p = o; }
__device__ __forceinline__ void st_bf4(bf16_t* p, f32x4 v) { u32x2 o; o.x = cvt_pk_bf16(v[0], v[1]); o.y = cvt_pk_bf16(v[2], v[3]); *(u32x2*)p = o; }
__device__ __forceinline__ int opq(int v) { asm volatile("" : "+s"(v)); return v; }
__device__ __forceinline__ int otid() { int t = threadIdx.x; asm volatile("" : "+v"(t)); return t; }
__device__ __forceinline__ float sigmoidf_(float x) { return 1.0f / (1.0f + __expf(-x)); }
__device__ __forceinline__ float tanhf_(float x) { return 1.0f - 2.0f / (__expf(2.0f * x) + 1.0f); }
__device__ __forceinline__ float wave_sum(float v) {
#pragma unroll
    for (int o = 32; o >= 1; o >>= 1) v += __shfl_xor(v, o);
    return v;
}
template <int CTRL> __device__ __forceinline__ float dppf(float x) { return __builtin_bit_cast(float, __builtin_amdgcn_mov_dpp(__builtin_bit_cast(int, x), CTRL, 0xf, 0xf, true)); }
__device__ __forceinline__ float row16_sum(float v) {
    v += dppf<0x128>(v); v += dppf<0x124>(v); v += dppf<0x122>(v); v += dppf<0x121>(v); return v;
}

#define XB_TMO      128
#define XB_XCNT(j)  (256  + 64 * (j))
#define XB_XSUB(j)  (1280 + 64 * (j))
#define XB_XGEN(j)  (2304 + 64 * (j))
#define XB_TOP      3328
#define XB_TOPGEN   3392
#define XCD_BAR_WORDS 3456
#define XB_SPIN_CAP (1u << 22)
__device__ __forceinline__ unsigned xb_ld(unsigned* p)              { return __hip_atomic_load(p, __ATOMIC_RELAXED, __HIP_MEMORY_SCOPE_AGENT); }
__device__ __forceinline__ unsigned xb_add(unsigned* p, unsigned v) { return __hip_atomic_fetch_add(p, v, __ATOMIC_RELAXED, __HIP_MEMORY_SCOPE_AGENT); }
__device__ __forceinline__ unsigned xb_xcc_id() { return (unsigned)__builtin_amdgcn_s_getreg((3 << 11) | 20) & 0xFu; }
#define XB_SPIN(cond, bar) do { unsigned _sp = 0; while (cond) { __builtin_amdgcn_s_sleep(1); \
    if ((++_sp & 255u) == 0u) { if (xb_ld(&(bar)[XB_TMO])) break; if (_sp > XB_SPIN_CAP) { atomicAdd(&(bar)[XB_TMO], 1u); break; } } } } while (0)
struct XcdBarrier { unsigned* bar; unsigned x; volatile LAS unsigned* st; };
__device__ __forceinline__ XcdBarrier xcd_barrier_post(unsigned* bar, volatile LAS unsigned* st) {
    XcdBarrier b; b.bar = bar; b.x = xb_xcc_id(); b.st = st;
    if (threadIdx.x == 0) (void)xb_add(&bar[XB_XCNT(b.x)], 1u);
    return b;
}
__device__ __forceinline__ void xcd_barrier_complete(unsigned* bar, unsigned x, unsigned& nloc, unsigned& nx) {
    const unsigned G = gridDim.x * gridDim.y * gridDim.z;
    unsigned sum, cnt, mine, sp = 0u;
    for (;;) {
        sum = 0u; cnt = 0u; mine = 0u;
#pragma unroll
        for (unsigned j = 0; j < 16; ++j) { const unsigned c = xb_ld(&bar[XB_XCNT(j)]); sum += c; cnt += (c > 0u) ? 1u : 0u; mine = (j == x) ? c : mine; }
        if (sum == G) break;
        __builtin_amdgcn_s_sleep(1);
        if ((++sp & 255u) == 0u) { if (xb_ld(&bar[XB_TMO])) break; if (sp > XB_SPIN_CAP) { atomicAdd(&bar[XB_TMO], 1u); break; } }
    }
    nloc = mine > 0u ? mine : 1u; nx = cnt > 0u ? cnt : 1u;
}
__device__ __forceinline__ void xcd_barrier(const XcdBarrier& b) {
    asm volatile("s_waitcnt vmcnt(0)" ::: "memory");
    __syncthreads();
    if (threadIdx.x == 0) {
        unsigned* bar = b.bar;
        const unsigned bx = (unsigned)opq((int)xb_xcc_id());
        __builtin_amdgcn_s_waitcnt(0);
        unsigned nloc = b.st[0], nx = b.st[1];
        if (nloc == 0u) { xcd_barrier_complete(bar, bx, nloc, nx); b.st[0] = nloc; b.st[1] = nx; }
        const unsigned old = xb_add(&bar[XB_XSUB(bx)], 1u);
        const unsigned gen = old / nloc;
        if (old + 1u == (gen + 1u) * nloc) {
            __builtin_amdgcn_fence(__ATOMIC_RELEASE, "agent");
            asm volatile("s_waitcnt vmcnt(0)" ::: "memory");
            const unsigned og = xb_add(&bar[XB_TOP], 1u);
            const unsigned tg = og / nx;
            if (og + 1u == (tg + 1u) * nx) xb_add(&bar[XB_TOPGEN], 1u);
            else XB_SPIN(xb_ld(&bar[XB_TOPGEN]) == tg, bar);
            __builtin_amdgcn_fence(__ATOMIC_ACQUIRE, "agent");
            xb_add(&bar[XB_XGEN(bx)], 1u);
            asm volatile("s_waitcnt vmcnt(0)" ::: "memory");
        } else {
            XB_SPIN(xb_ld(&bar[XB_XGEN(bx)]) == gen, bar);
            __builtin_amdgcn_fence(__ATOMIC_ACQUIRE, "agent");
            asm volatile("s_waitcnt vmcnt(0)" ::: "memory");
        }
    }
    __syncthreads();
}

namespace pg8 {
constexpr int BM = 256, BK = 64, HALF = 128, HTB = HALF * BK * 2, NXCD = 8, WGM = 8;
__host__ __device__ __forceinline__ int lds_byte(int r, int c) { const int st = (r >> 4) * 2 + (c >> 5), rr = r & 15, cc = c & 31, ob = rr * 64 + cc * 2; return st * 1024 + (ob ^ (((ob >> 9) & 1) << 5)); }
__host__ __device__ __forceinline__ void stage_rc(int b, int& R, int& C) { const int st = b / 1024, sb = b % 1024, swz = sb ^ (((sb >> 9) & 1) << 5); R = (st >> 1) * 16 + swz / 64; C = (st & 1) * 32 + (swz % 64) / 2; }
__host__ __device__ __forceinline__ int perm32(int rho) { const int n = rho >> 4, i = rho & 15; return 8 * (i >> 2) + 4 * n + (i & 3); }

struct Unit { int pm, pn; };
struct Gemm { const char* A; const char* Bt; int nM, nN, K, lda; int pad16; int agrp; size_t go1, go2, go3; };

struct StaticOrder {
    int nM, nN, nwg, G, c, skew;
    __device__ void init(int nM_, int nN_, int G_, int c_) { nM = nM_; nN = nN_; nwg = nM * nN; G = G_; c = c_; skew = 0; }
    __device__ bool next(int i, Unit& u) const {
        long L = (long)i * G + c;
        if (skew) { if (c >= 128) { if (i >= 4) return false; L = 4 * (c - 128) + i; } else { if (i >= 2) return false; L = 512 + 2 * c + i; } }
        if (L >= nwg) return false;
        int wgid = (int)L; { const int q = nwg / NXCD, r = nwg % NXCD, xcd = wgid % NXCD, off = wgid / NXCD; wgid = (xcd < r ? xcd * (q + 1) : r * (q + 1) + (xcd - r) * q) + off; }
        const int nig = WGM * nN, gid = wgid / nig, fm = gid * WGM, gsz = (nM - fm) < WGM ? (nM - fm) : WGM;
        u.pm = fm + ((wgid % nig) % gsz); u.pn = (wgid % nig) / gsz; return true;
    }
};

template <class Epi>
__device__ __forceinline__ void gemm_phase(LAS unsigned char* lds, const Gemm g, const StaticOrder& S, const Epi& E) {
    const int tid = otid(), wid = __builtin_amdgcn_readfirstlane(tid >> 6), lane = tid & 63, wr = wid >> 2, wc = wid & 3, fr = lane & 15, fq = lane >> 4;
    const int K = g.K, nt = K / BK, lda = g.lda;
    unsigned voffA[2], voffB[2];
#pragma unroll
    for (int i = 0; i < 2; ++i) { int R, C; stage_rc(tid * 16 + i * 8192, R, C); const int Rb = Epi::PERM ? ((R & ~31) + perm32(R & 31)) : R;
        voffA[i] = (unsigned)(R * lda + C) * 2u; voffB[i] = (unsigned)(Rb * K + C) * 2u; }
    const size_t kstep = (size_t)(BK * 2);
    const size_t hstepA = (size_t)HALF * lda * 2, hstepB = (size_t)HALF * K * 2;
    const size_t tstepA = 2 * hstepA, tstepB = 2 * hstepB;
    const unsigned ldsw = (unsigned)wid * 1024u;
    const int aoff = lds_byte(wr * 64 + fr, fq * 8), boff = lds_byte(wc * 32 + fr, fq * 8);
#define PG8_SA(b, h) (((b) * 2 + (h)) * HTB)
#define PG8_SB(b, h) ((4 + (b) * 2 + (h)) * HTB)
#define PG8_STAGE(bufoff, gbase, voff) do { _Pragma("unroll") for (int _i = 0; _i < 2; ++_i) \
        __builtin_amdgcn_global_load_lds((const unsigned*)((const char*)(gbase) + (voff)[_i]), (LAS unsigned*)(lds + (bufoff) + ldsw + _i * 8192), 16, 0, 0); } while (0)
#define PG8_LDA(dst, b, h) do { _Pragma("unroll") for (int m = 0; m < 4; ++m) _Pragma("unroll") for (int k = 0; k < 2; ++k) dst[m][k] = *(const LAS bf16x8*)(lds + PG8_SA(b, h) + aoff + m * 2048 + k * 1024); } while (0)
#define PG8_LDB(dst, b, h) do { _Pragma("unroll") for (int n = 0; n < 2; ++n) _Pragma("unroll") for (int k = 0; k < 2; ++k) dst[n][k] = *(const LAS bf16x8*)(lds + PG8_SB(b, h) + boff + n * 2048 + k * 1024); } while (0)
#define PG8_MMA(ai, bj, At, Bt) do { __builtin_amdgcn_s_setprio(1); _Pragma("unroll") for (int m = 0; m < 4; ++m) _Pragma("unroll") for (int n = 0; n < 2; ++n) _Pragma("unroll") for (int k = 0; k < 2; ++k) \
        acc[ai][bj][m][n] = __builtin_amdgcn_mfma_f32_16x16x32_bf16(Bt[n][k], At[m][k], acc[ai][bj][m][n], 0, 0, 0); __builtin_amdgcn_s_setprio(0); } while (0)
#define PG8_WAIT_V(n) asm volatile("s_waitcnt vmcnt(" #n ")" ::: "memory")
#define PG8_WAIT_L(n) asm volatile("s_waitcnt lgkmcnt(" #n ")" ::: "memory")
#define PG8_BAR __builtin_amdgcn_s_barrier()
#define PG8_SCHED __builtin_amdgcn_sched_barrier(0)
#define PG8_APTR(u) (g.A + (size_t)((u).pm + (g.pad16 ? ((u).pm >> 4) : 0)) * tstepA + (((u).pn / g.agrp) == 0 ? (size_t)0 : ((u).pn / g.agrp) == 1 ? g.go1 : ((u).pn / g.agrp) == 2 ? g.go2 : g.go3))
    Unit cur, nxt; int ui = 0;
    if (!S.next(0, cur)) return;
    if constexpr (Epi::HAS_PRO) E.prologue(cur);
    f32x4 acc[2][2][4][2];
#pragma unroll
    for (int a = 0; a < 2; ++a)
#pragma unroll
        for (int b = 0; b < 2; ++b)
#pragma unroll
            for (int m = 0; m < 4; ++m)
#pragma unroll
                for (int n = 0; n < 2; ++n) acc[a][b][m][n] = (f32x4){0.f, 0.f, 0.f, 0.f};
    bf16x8 At[4][2], B0[2][2], B1[2][2];
    const char* cA = PG8_APTR(cur); const char* cB = g.Bt + (size_t)cur.pn * tstepB;
    PG8_STAGE(PG8_SB(0, 0), cB, voffB); PG8_STAGE(PG8_SB(0, 1), cB + hstepB, voffB); PG8_STAGE(PG8_SA(0, 0), cA, voffA); PG8_STAGE(PG8_SA(0, 1), cA + hstepA, voffA);
    if (wr == 1) PG8_BAR;
    PG8_WAIT_V(2); PG8_BAR;
    PG8_STAGE(PG8_SB(1, 0), cB + kstep, voffB); PG8_STAGE(PG8_SA(1, 0), cA + kstep, voffA); PG8_STAGE(PG8_SB(1, 1), cB + hstepB + kstep, voffB);
    PG8_WAIT_V(6); PG8_BAR;
    for (;;) {
        const bool has_next = S.next(ui + 1, nxt);
        const char* nA = has_next ? PG8_APTR(nxt) : cA; const char* nB = has_next ? g.Bt + (size_t)nxt.pn * tstepB : cB;
        for (int t = 0; t < nt; t += 2) {
            const bool last = (t == nt - 2);
            const char* a1 = cA + (size_t)(t + 1) * kstep;
            const char* a2 = last ? nA : cA + (size_t)(t + 2) * kstep; const char* b2 = last ? nB : cB + (size_t)(t + 2) * kstep;
            const char* a3 = a2 + kstep; const char* b3 = b2 + kstep;
            PG8_LDB(B0, 0, 0); PG8_LDB(B1, 0, 1); PG8_SCHED; PG8_LDA(At, 0, 0); PG8_STAGE(PG8_SA(1, 1), a1 + hstepA, voffA);
            PG8_WAIT_V(8); PG8_WAIT_L(0); PG8_BAR; PG8_MMA(0, 0, At, B0); PG8_MMA(0, 1, At, B1); PG8_BAR; PG8_SCHED;
            PG8_LDA(At, 0, 1); PG8_STAGE(PG8_SB(0, 0), b2, voffB); PG8_STAGE(PG8_SB(0, 1), b2 + hstepB, voffB); PG8_STAGE(PG8_SA(0, 0), a2, voffA);
            PG8_WAIT_V(8); PG8_WAIT_L(0); PG8_BAR; PG8_MMA(1, 0, At, B0); PG8_MMA(1, 1, At, B1); PG8_BAR; PG8_SCHED;
            PG8_LDB(B0, 1, 0); PG8_LDB(B1, 1, 1); PG8_SCHED; PG8_LDA(At, 1, 0); PG8_STAGE(PG8_SA(0, 1), a2 + hstepA, voffA);
            PG8_WAIT_V(8); PG8_WAIT_L(0); PG8_BAR; PG8_MMA(0, 0, At, B0); PG8_MMA(0, 1, At, B1); PG8_BAR; PG8_SCHED;
            PG8_LDA(At, 1, 1); PG8_STAGE(PG8_SB(1, 0), b3, voffB); PG8_STAGE(PG8_SB(1, 1), b3 + hstepB, voffB); PG8_STAGE(PG8_SA(1, 0), a3, voffA);
            PG8_WAIT_V(8); PG8_WAIT_L(0); PG8_BAR; PG8_MMA(1, 0, At, B0); PG8_MMA(1, 1, At, B1); PG8_BAR; PG8_SCHED;
        }
        if (wr == 0) PG8_BAR;
        E(acc, cur, wr, wc, fr, fq);
        if (!has_next) break;
#pragma unroll
        for (int a = 0; a < 2; ++a)
#pragma unroll
            for (int b = 0; b < 2; ++b)
#pragma unroll
                for (int m = 0; m < 4; ++m)
#pragma unroll
                    for (int n = 0; n < 2; ++n) acc[a][b][m][n] = (f32x4){0.f, 0.f, 0.f, 0.f};
        cur = nxt; cA = nA; cB = nB; ++ui;
        if (wr == 1) PG8_BAR;
    }
    PG8_WAIT_V(0);
    PG8_BAR;
#undef PG8_SA
#undef PG8_SB
#undef PG8_STAGE
#undef PG8_LDA
#undef PG8_LDB
#undef PG8_MMA
#undef PG8_WAIT_V
#undef PG8_WAIT_L
#undef PG8_BAR
#undef PG8_SCHED
#undef PG8_APTR
}

template <int ACT  , bool NORM = false> struct EpiBf16 {
    static constexpr bool PERM = true, HAS_PRO = NORM;
    bf16_t* O0; bf16_t* O1; bf16_t* O2; int ldc; int split;
    const float* ssq; const float* shw; int shw_ld; LAS float* rl;
    __device__ __forceinline__ void prologue(const Unit& u) const {
        if (NORM) { const int t = otid();
            if (t < 256) { const float* pp = ssq + (size_t)(u.pm * BM + t) * 16; const f32x4 q0 = *(const f32x4*)pp, q1 = *(const f32x4*)(pp + 4), q2 = *(const f32x4*)(pp + 8), q3 = *(const f32x4*)(pp + 12);
                const f32x4 q = (q0 + q1) + (q2 + q3); rl[t] = rsqrtf(((q[0] + q[1]) + (q[2] + q[3])) * (1.0f / D) + 1e-6f); }
            if (t == 256) ((LAS int*)rl)[256] = opq(u.pm); }
    }
    __device__ __forceinline__ void operator()(const f32x4 (&acc)[2][2][4][2], const Unit& u, int wr, int wc, int fr, int fq) const {
        const int row0 = u.pm * BM + wr * 64 + fr; int pn = u.pn; bf16_t* base = O0;
        if (split) { const int t = pn / split; base = (t == 0) ? O0 : (t == 1) ? O1 : O2; pn -= t * split; }
        const int col0 = pn * BM + wc * 32 + 8 * fq;
        f32x4 sv[2][2]; bool fast = true;
        if (NORM) { const float* sp = shw + (size_t)(u.pm >> 4) * shw_ld + col0; fast = (((const LAS int*)rl)[256] == u.pm);
#pragma unroll
            for (int bj = 0; bj < 2; ++bj) { sv[bj][0] = *(const f32x4*)(sp + bj * HALF); sv[bj][1] = *(const f32x4*)(sp + bj * HALF + 4); } }
#pragma unroll
        for (int ai = 0; ai < 2; ++ai)
#pragma unroll
            for (int m = 0; m < 4; ++m) { bf16_t* rowp = base + (size_t)(row0 + ai * HALF + m * 16) * ldc + col0;
                float ri = 1.f;
                if (NORM) { if (fast) ri = rl[wr * 64 + fr + ai * HALF + m * 16];
                    else { const float* pp = ssq + (size_t)(row0 + ai * HALF + m * 16) * 16; const f32x4 q0 = *(const f32x4*)pp, q1 = *(const f32x4*)(pp + 4), q2 = *(const f32x4*)(pp + 8), q3 = *(const f32x4*)(pp + 12);
                        const f32x4 q = (q0 + q1) + (q2 + q3); ri = rsqrtf(((q[0] + q[1]) + (q[2] + q[3])) * (1.0f / D) + 1e-6f); } }
#pragma unroll
                for (int bj = 0; bj < 2; ++bj) { f32x4 v0 = acc[ai][bj][m][0], v1 = acc[ai][bj][m][1];
                    if (NORM) { v0 = v0 * ri + sv[bj][0]; v1 = v1 * ri + sv[bj][1]; }
                    if (ACT == 1) {
#pragma unroll
                        for (int j = 0; j < 4; ++j) { const float a = fmaxf(v0[j], 0.f), b = fmaxf(v1[j], 0.f); v0[j] = a * a; v1[j] = b * b; } }
                    if (ACT == 2) { const int c4 = col0 + bj * HALF;
                        if (c4 < 64) {
#pragma unroll
                            for (int j = 0; j < 4; ++j) { v0[j] = tanhf_(v0[j]); v1[j] = tanhf_(v1[j]); } }
                        else if (c4 >= 128 && c4 < 288) {
#pragma unroll
                            for (int j = 0; j < 4; ++j) { v0[j] = sigmoidf_(v0[j]); v1[j] = sigmoidf_(v1[j]); } } }
                    u32x4 w; w.x = cvt_pk_bf16(v0[0], v0[1]); w.y = cvt_pk_bf16(v0[2], v0[3]); w.z = cvt_pk_bf16(v1[0], v1[1]); w.w = cvt_pk_bf16(v1[2], v1[3]);
                    *(u32x4*)(rowp + bj * HALF) = w; } }
    }
};
struct EpiResid {
    static constexpr bool PERM = false, HAS_PRO = false;
    const float* src; float* dst; const float* gate;
    int emit; bf16_t* HBo; const float* gg; float* ssq;
    __device__ __forceinline__ void operator()(const f32x4 (&acc)[2][2][4][2], const Unit& u, int wr, int wc, int fr, int fq) const {
        const int row0 = u.pm * BM + wr * 64 + fr, col0 = u.pn * BM + wc * 32 + 4 * fq, b = u.pm >> 4;
        const float* gp = gate + (size_t)b * NMOD + col0;
        f32x4 gv[2][2], g2[2][2];
#pragma unroll
        for (int bj = 0; bj < 2; ++bj)
#pragma unroll
            for (int n = 0; n < 2; ++n) { gv[bj][n] = *(const f32x4*)(gp + bj * HALF + n * 16); g2[bj][n] = emit ? *(const f32x4*)(gg + (size_t)b * D + col0 + bj * HALF + n * 16) : (f32x4){0.f, 0.f, 0.f, 0.f}; }
#pragma unroll
        for (int ai = 0; ai < 2; ++ai)
#pragma unroll
            for (int m = 0; m < 4; ++m) { const int row = row0 + ai * HALF + m * 16; const size_t off = (size_t)row * D + col0;
                const size_t hoff = (size_t)(b * HROWS + PADROWS + (row & (SEQ - 1))) * D + col0; float ss = 0.f;
#pragma unroll
                for (int bj = 0; bj < 2; ++bj)
#pragma unroll
                    for (int n = 0; n < 2; ++n) { const f32x4 s = *(const f32x4*)(src + off + bj * HALF + n * 16);
                        const f32x4 xn = s + gv[bj][n] * acc[ai][bj][m][n];
                        *(f32x4*)(dst + off + bj * HALF + n * 16) = xn;
                        if (emit) { ss += xn[0] * xn[0] + xn[1] * xn[1] + xn[2] * xn[2] + xn[3] * xn[3]; st_bf4(HBo + hoff + bj * HALF + n * 16, xn * g2[bj][n]); } }
                if (emit) { ss += __shfl_xor(ss, 16); ss += __shfl_xor(ss, 32); if (fq == 0) ssq[(size_t)row * 16 + u.pn * 4 + wc] = ss; } }
    }
};
struct EpiLora2 {
    static constexpr bool PERM = true, HAS_PRO = false;
    bf16_t* EW; bf16_t* AB; bf16_t* GB; bf16_t* V; const bf16_t* VF; const float* w0; const float* a0; const float* v0;
    template <int GRP>
    __device__ __forceinline__ void body(const f32x4 (&acc)[2][2][4][2], const Unit& u, int wr, int wc, int fr, int fq, bf16_t* outp, const float* bias) const {
        const int row0 = u.pm * BM + wr * 64 + fr, col0 = (u.pn & 3) * BM + wc * 32 + 8 * fq;
        f32x4 bv[2][2];
#pragma unroll
        for (int bj = 0; bj < 2; ++bj)
#pragma unroll
            for (int n = 0; n < 2; ++n) bv[bj][n] = (GRP == 2) ? (f32x4){0.f, 0.f, 0.f, 0.f} : *(const f32x4*)(bias + col0 + bj * HALF + 4 * n);
#pragma unroll
        for (int ai = 0; ai < 2; ++ai)
#pragma unroll
            for (int m = 0; m < 4; ++m) { const size_t off = (size_t)(row0 + ai * HALF + m * 16) * D + col0;
#pragma unroll
                for (int bj = 0; bj < 2; ++bj) { f32x4 v0_ = acc[ai][bj][m][0] + bv[bj][0], v1_ = acc[ai][bj][m][1] + bv[bj][1];
                    if (GRP == 0) {
#pragma unroll
                        for (int j = 0; j < 4; ++j) { v0_[j] = 0.60653066f * sigmoidf_(v0_[j]); v1_[j] = 0.60653066f * sigmoidf_(v1_[j]); } }
                    else if (GRP == 1) {
#pragma unroll
                        for (int j = 0; j < 4; ++j) { v0_[j] = sigmoidf_(v0_[j]); v1_[j] = sigmoidf_(v1_[j]); } }
                    else if (GRP == 3) {
                        const u32x4 vv = *(const u32x4*)(outp + off + bj * HALF), ff = *(const u32x4*)(VF + off + bj * HALF);
                        const f32x4 va = (f32x4){bflo(vv.x), bfhi(vv.x), bflo(vv.y), bfhi(vv.y)}, vb = (f32x4){bflo(vv.z), bfhi(vv.z), bflo(vv.w), bfhi(vv.w)};
                        const f32x4 fa = (f32x4){bflo(ff.x), bfhi(ff.x), bflo(ff.y), bfhi(ff.y)}, fb = (f32x4){bflo(ff.z), bfhi(ff.z), bflo(ff.w), bfhi(ff.w)};
#pragma unroll
                        for (int j = 0; j < 4; ++j) { v0_[j] = va[j] + (fa[j] - va[j]) * sigmoidf_(v0_[j]); v1_[j] = vb[j] + (fb[j] - vb[j]) * sigmoidf_(v1_[j]); } }
                    u32x4 w; w.x = cvt_pk_bf16(v0_[0], v0_[1]); w.y = cvt_pk_bf16(v0_[2], v0_[3]); w.z = cvt_pk_bf16(v1_[0], v1_[1]); w.w = cvt_pk_bf16(v1_[2], v1_[3]);
                    *(u32x4*)(outp + off + bj * HALF) = w; } }
    }
    __device__ __forceinline__ void operator()(const f32x4 (&acc)[2][2][4][2], const Unit& u, int wr, int wc, int fr, int fq) const {
        const int grp = u.pn >> 2;
        if (grp == 0) body<0>(acc, u, wr, wc, fr, fq, EW, w0);
        else if (grp == 1) body<1>(acc, u, wr, wc, fr, fq, AB, a0);
        else if (grp == 2) body<2>(acc, u, wr, wc, fr, fq, GB, a0);
        else body<3>(acc, u, wr, wc, fr, fq, V, v0);
    }
};
}

__device__ __forceinline__ void p0_prologue(const Params& p, LAS unsigned char* lds) {
    const int tid = otid(), wid = tid >> 6, lane = tid & 63;
    unsigned char* ws = p.ws;
    LAS float* tile = (LAS float*)lds;
    LAS float* sc = (LAS float*)(lds + 69632);
    LAS float* part = (LAS float*)(lds + 69632 + 16384);
    const float* cin = p.in[1];
    for (int i = tid; i < NB * D; i += NTHREADS) { const float v = cin[i]; sc[i] = v / (1.0f + __expf(-v)); }
    __syncthreads();
    constexpr int N_GEMV = 4 * 48, N_TR = 3072;
    for (int task = blockIdx.x; task < N_GEMV + N_TR; task += gridDim.x) {
        if (task < N_GEMV) {
            const int layer = task / 48, n0 = (task % 48) * 128;
            const float* W = p.in[4] + (size_t)layer * D * NMOD + n0 + lane * 2;
            float a0x = 0.f, a0y = 0.f, a1x = 0.f, a1y = 0.f, a2x = 0.f, a2y = 0.f, a3x = 0.f, a3y = 0.f;
            const int k0 = wid * 128;
#pragma unroll 8
            for (int k = 0; k < 128; ++k) {
                const f32x2 w = *(const f32x2*)(W + (size_t)(k0 + k) * NMOD);
                const float c0 = sc[k0 + k], c1 = sc[D + k0 + k], c2 = sc[2 * D + k0 + k], c3 = sc[3 * D + k0 + k];
                a0x += c0 * w.x; a0y += c0 * w.y; a1x += c1 * w.x; a1y += c1 * w.y; a2x += c2 * w.x; a2y += c2 * w.y; a3x += c3 * w.x; a3y += c3 * w.y;
            }
            LAS float* pp = part + wid * 512 + lane * 2;
            pp[0] = a0x; pp[1] = a0y; pp[128] = a1x; pp[129] = a1y; pp[256] = a2x; pp[257] = a2y; pp[384] = a3x; pp[385] = a3y;
            __syncthreads();
            { const int b = tid >> 7, col = tid & 127; float s = 0.f;
#pragma unroll
              for (int w = 0; w < 8; ++w) s += part[w * 512 + b * 128 + col];
              ((float*)(ws + WS_MOD))[(size_t)(layer * NB + b) * NMOD + n0 + col] = s + p.in[5][(size_t)layer * NMOD + n0 + col]; }
            __syncthreads();
        } else {
            int t = task - N_GEMV; const float* src; bf16_t* dst; int Ks, Ns;
            if (t < 1024) { const int i = t >> 8; t &= 255; src = p.in[28] + (size_t)i * D * FF; dst = (bf16_t*)(ws + WS_W1T) + (size_t)i * D * FF; Ks = D; Ns = FF; }
            else if (t < 2048) { t -= 1024; const int i = t >> 8; t &= 255; src = p.in[29] + (size_t)i * D * FF; dst = (bf16_t*)(ws + WS_W2T) + (size_t)i * D * FF; Ks = FF; Ns = D; }
            else if (t < 2432) { t -= 2048; const int i = t / 192; t %= 192; src = p.in[6] + (size_t)i * D * 3 * D; dst = (bf16_t*)(ws + WS_WINT) + (size_t)i * D * 3 * D; Ks = D; Ns = 3 * D; }
            else { t -= 2432; const int mi = t >> 6; t &= 63; Ks = D; Ns = D;
                if (mi < 2) { src = p.in[8] + (size_t)mi * D * D; dst = (bf16_t*)(ws + WS_WOUTT) + (size_t)mi * D * D; }
                else if (mi < 8) { src = p.in[10] + (size_t)(mi - 2) * D * D; dst = (bf16_t*)(ws + WS_RKVT) + (size_t)(mi - 2) * D * D; }
                else { src = p.in[11] + (size_t)(mi - 8) * D * D; dst = (bf16_t*)(ws + WS_WOT) + (size_t)(mi - 8) * D * D; } }
            const int ntn = Ns >> 7, k0 = (t / ntn) * 128, n0 = (t % ntn) * 128;
#pragma unroll
            for (int it = 0; it < 8; ++it) { const int k = it * 16 + (tid >> 5), n = (tid & 31) * 4;
                const f32x4 v = *(const f32x4*)(src + (size_t)(k0 + k) * Ns + n0 + n);
                *(LAS f32x4*)(tile + k * 132 + n) = v; }
            __syncthreads();
#pragma unroll
            for (int it = 0; it < 4; ++it) { const int n = tid & 127, ko = (tid >> 7) + 4 * it;
                float v[8];
#pragma unroll
                for (int j = 0; j < 8; ++j) v[j] = tile[(ko * 8 + j) * 132 + n];
                u32x4 w; w.x = cvt_pk_bf16(v[0], v[1]); w.y = cvt_pk_bf16(v[2], v[3]); w.z = cvt_pk_bf16(v[4], v[5]); w.w = cvt_pk_bf16(v[6], v[7]);
                *(u32x4*)(dst + (size_t)(n0 + n) * Ks + k0 + ko * 8) = w; }
            __syncthreads();
        }
    }
    const size_t gtid = (size_t)blockIdx.x * NTHREADS + tid, gsz = (size_t)gridDim.x * NTHREADS;
    for (size_t e = gtid; e < (size_t)2 * 512 * 2048; e += gsz) {
        const int j = (int)(e >> 20), n = (int)((e >> 11) & 511), k = (int)(e & 2047), kk = k & 1023; const bool first = k < 1024;
        float w = 0.f; int mi = -1;
        if (n < 64) { w = p.in[13][(size_t)j * D * 64 + (size_t)kk * 64 + n]; mi = 1; }
        else if (n < 128) { w = p.in[16][(size_t)j * D * 64 + (size_t)kk * 64 + (n - 64)]; mi = 4; }
        else if (n < 288) { w = p.in[18][(size_t)j * D * 160 + (size_t)kk * 160 + (n - 128)]; mi = 5; }
        else if (n < 320 && j == 1) { w = p.in[26][(size_t)kk * 32 + (n - 288)]; mi = 3; }
        if (mi >= 0) { const float mu = p.in[9][(size_t)j * 6 * D + mi * D + kk]; w *= first ? mu : (1.0f - mu); }
        ((bf16_t*)(ws + WS_L1T))[e] = (bf16_t)(cvt_pk_bf16(w, 0.f) & 0xffffu);
    }
    for (size_t e = gtid; e < (size_t)2 * 4096 * 256; e += gsz) {
        const int j = (int)(e >> 20), n = (int)((e >> 8) & 4095), k = (int)(e & 255), grp = n >> 10, nn = n & 1023;
        float w = 0.f;
        if (grp == 0) { if (k < 64) w = p.in[14][(size_t)j * 64 * D + (size_t)k * D + nn]; }
        else if (grp == 1) { if (k >= 64 && k < 128) w = p.in[17][(size_t)j * 64 * D + (size_t)(k - 64) * D + nn]; }
        else if (grp == 2) { if (k < 160) w = p.in[19][(size_t)j * 160 * D + (size_t)k * D + nn]; }
        else { if (j == 1 && k >= 32 && k < 64) w = p.in[27][(size_t)(k - 32) * D + nn]; }
        ((bf16_t*)(ws + WS_L2T))[e] = (bf16_t)(cvt_pk_bf16(w, 0.f) & 0xffffu);
    }
}

template <int MODE>
__device__ __forceinline__ void norm_phase(const float* x, const float* g, const float* mod_sh, const float* mod_sc, bf16_t* HB,
                                           const float* mu, bf16_t* XR, bf16_t* XK, bf16_t* XV, float* ssq_out = nullptr) {
    const int tid_ = otid(), lane = tid_ & 63, gw = blockIdx.x * 8 + (tid_ >> 6), GW = gridDim.x * 8;
    constexpr int NT = (MODE == 1) ? 2 : 4;
    for (int tok0 = gw; tok0 < M; tok0 += NT * GW) {
        f32x4 xv[NT][4], xp[NT][4]; float ss[NT], sp[NT];
#pragma unroll
        for (int u = 0; u < NT; ++u) { ss[u] = 0.f; sp[u] = 0.f; }
#pragma unroll
        for (int u = 0; u < NT; ++u) { const int tok = tok0 + u * GW; const bool ok = tok < M; const int s = tok & (SEQ - 1);
#pragma unroll
            for (int j = 0; j < 4; ++j) { xv[u][j] = ok ? *(const f32x4*)(x + (size_t)tok * D + j * 256 + lane * 4) : (f32x4){0.f, 0.f, 0.f, 0.f};
                if (MODE == 1) xp[u][j] = (ok && s > 0) ? *(const f32x4*)(x + (size_t)(tok - 1) * D + j * 256 + lane * 4) : (f32x4){0.f, 0.f, 0.f, 0.f}; } }
#pragma unroll
        for (int u = 0; u < NT; ++u)
#pragma unroll
            for (int j = 0; j < 4; ++j) { ss[u] += xv[u][j][0] * xv[u][j][0] + xv[u][j][1] * xv[u][j][1] + xv[u][j][2] * xv[u][j][2] + xv[u][j][3] * xv[u][j][3];
                if (MODE == 1) sp[u] += xp[u][j][0] * xp[u][j][0] + xp[u][j][1] * xp[u][j][1] + xp[u][j][2] * xp[u][j][2] + xp[u][j][3] * xp[u][j][3]; }
#pragma unroll
        for (int u = 0; u < NT; ++u) { const int tok = tok0 + u * GW; if (tok >= M) break;
            const int b = tok >> 12, s = tok & (SEQ - 1);
            const float ssw = wave_sum(ss[u]);
            const float ri = (MODE == 2) ? 1.0f : rsqrtf(ssw * (1.0f / D) + 1e-6f);
            if (MODE == 2) { if (lane < 16) ssq_out[(size_t)tok * 16 + lane] = (lane == 0) ? ssw : 0.f; }
            float rp = 0.f; if (MODE == 1) rp = rsqrtf(wave_sum(sp[u]) * (1.0f / D) + 1e-6f);
            const size_t hrow = (size_t)(b * HROWS + PADROWS + s) * D;
#pragma unroll
            for (int j = 0; j < 4; ++j) { const int c = j * 256 + lane * 4;
                const f32x4 gv = *(const f32x4*)(g + c), shv = *(const f32x4*)(mod_sh + (size_t)b * NMOD + c), scv = *(const f32x4*)(mod_sc + (size_t)b * NMOD + c);
                const f32x4 h = (MODE == 2) ? xv[u][j] * gv * (1.0f + scv) : xv[u][j] * ri * gv * (1.0f + scv) + shv;
                st_bf4(HB + hrow + c, h);
                if (MODE == 1) {
                    f32x4 hp = xp[u][j] * rp * gv * (1.0f + scv) + shv; if (s == 0) hp = (f32x4){0.f, 0.f, 0.f, 0.f};
                    const f32x4 xx = hp - h;
                    const f32x4 mr = *(const f32x4*)(mu + c), mk = *(const f32x4*)(mu + 2 * D + c), mv = *(const f32x4*)(mu + 3 * D + c);
                    st_bf4(XR + (size_t)tok * D + c, h + xx * mr); st_bf4(XK + (size_t)tok * D + c, h + xx * mk); st_bf4(XV + (size_t)tok * D + c, h + xx * mv);
                    if (s == 0) *(u32x2*)(HB + hrow - D + c) = (u32x2){0u, 0u};
                } } }
    }
}

__device__ __forceinline__ void conv_phase(const bf16_t* BCH, const float* cw, bf16_t* Z) {
    const int tid_ = otid(), lane = tid_ & 63, gw = blockIdx.x * 8 + (tid_ >> 6), GW = gridDim.x * 8;
    for (int tok0 = gw; tok0 < M; tok0 += 2 * GW) {
        u32x2 rb[2][4], rc0[2][4], rh0[2][4], rc1[2][4], rh1[2][4], rc2[2][4], rh2[2][4];
#pragma unroll
        for (int u = 0; u < 2; ++u) { const int tok = tok0 + u * GW; const bool ok = tok < M; const int s = tok & (SEQ - 1);
#pragma unroll
            for (int j = 0; j < 4; ++j) { const bf16_t* rp = BCH + (size_t)tok * 3 * D + j * 256 + lane * 4; const u32x2 z2 = (u32x2){0u, 0u};
                rb[u][j] = ok ? *(const u32x2*)rp : z2; rc0[u][j] = ok ? *(const u32x2*)(rp + D) : z2; rh0[u][j] = ok ? *(const u32x2*)(rp + 2 * D) : z2;
                rc1[u][j] = (ok && s >= 1) ? *(const u32x2*)(rp - 2 * D) : z2; rh1[u][j] = (ok && s >= 1) ? *(const u32x2*)(rp - D) : z2;
                rc2[u][j] = (ok && s >= 2) ? *(const u32x2*)(rp - 5 * D) : z2; rh2[u][j] = (ok && s >= 2) ? *(const u32x2*)(rp - 4 * D) : z2; } }
#pragma unroll
        for (int u = 0; u < 2; ++u) { const int tok = tok0 + u * GW; if (tok >= M) break;
#pragma unroll
            for (int j = 0; j < 4; ++j) { const int c = j * 256 + lane * 4;
#define CV4(v) ((f32x4){bflo((v).x), bfhi((v).x), bflo((v).y), bfhi((v).y)})
                const f32x4 bg = CV4(rb[u][j]), u0 = CV4(rc0[u][j]) * CV4(rh0[u][j]), u1 = CV4(rc1[u][j]) * CV4(rh1[u][j]), u2 = CV4(rc2[u][j]) * CV4(rh2[u][j]);
#undef CV4
                const f32x4 w0 = *(const f32x4*)(cw + c), w1 = *(const f32x4*)(cw + D + c), w2 = *(const f32x4*)(cw + 2 * D + c);
                st_bf4(Z + (size_t)tok * D + c, bg * (w0 * u2 + w1 * u1 + w2 * u0)); } }
    }
}

namespace wk {
constexpr int MS = 72;
constexpr int MATB = 64 * MS * 2;
constexpr int CW_OFF = 11 * MATB;
constexpr int BT_OFF = 15 * MATB;
constexpr int WL_OFF = BT_OFF + 2048;
enum { AT = 0, RT = 1, BDT = 2, KDT = 3, VT = 4, MAKT = 5, MRBT = 6, MRKT = 7, SB = 8, BT_ = 9, KT_ = 10, PA = 11, PB = 12, TA = 13, TB = 14 };
__device__ __forceinline__ LAS bf16_t* mat(LAS unsigned char* lds, int i) { return (LAS bf16_t*)(lds + i * MATB); }
template <bool F16 = false>
__device__ __forceinline__ void mm2(f32x4 (&acc)[2], const LAS bf16_t* A, const LAS bf16_t* B, int mi, int ni0, int fr, int fq) {
#pragma unroll
    for (int ks = 0; ks < 2; ++ks) {
        const bf16x8 a = *(const LAS bf16x8*)(A + (mi * 16 + fr) * MS + ks * 32 + fq * 8);
#pragma unroll
        for (int n = 0; n < 2; ++n) { const bf16x8 b = *(const LAS bf16x8*)(B + ((ni0 + n) * 16 + fr) * MS + ks * 32 + fq * 8);
            if (F16) acc[n] = __builtin_amdgcn_mfma_f32_16x16x32_f16(__builtin_bit_cast(f16x8, a), __builtin_bit_cast(f16x8, b), acc[n], 0, 0, 0);
            else acc[n] = __builtin_amdgcn_mfma_f32_16x16x32_bf16(a, b, acc[n], 0, 0, 0); }
    }
}
__device__ __forceinline__ void st_rowmajor(LAS bf16_t* dst, const f32x4 c, int mi, int ni, int fr, int fq) {
    const unsigned lo = cvt_pk_bf16(c[0], c[1]), hi = cvt_pk_bf16(c[2], c[3]);
    LAS bf16_t* p = dst + (mi * 16 + fq * 4) * MS + ni * 16 + fr;
    p[0] = (bf16_t)(lo & 0xffffu); p[MS] = (bf16_t)(lo >> 16); p[2 * MS] = (bf16_t)(hi & 0xffffu); p[3 * MS] = (bf16_t)(hi >> 16);
}
__device__ __forceinline__ void st_rowmajor_h(LAS bf16_t* dst, const f32x4 c, int mi, int ni, int fr, int fq) {
    const unsigned lo = cvt_pk_f16(c[0], c[1]), hi = cvt_pk_f16(c[2], c[3]);
    LAS bf16_t* p = dst + (mi * 16 + fq * 4) * MS + ni * 16 + fr;
    p[0] = (bf16_t)(lo & 0xffffu); p[MS] = (bf16_t)(lo >> 16); p[2 * MS] = (bf16_t)(hi & 0xffffu); p[3 * MS] = (bf16_t)(hi >> 16);
}
__device__ __forceinline__ void st_transposed_h(LAS bf16_t* dst, const f32x4 c, int mi, int ni, int fr, int fq) {
    u32x2 w; w.x = cvt_pk_f16(c[0], c[1]); w.y = cvt_pk_f16(c[2], c[3]);
    *(LAS u32x2*)(dst + (ni * 16 + fr) * MS + mi * 16 + fq * 4) = w;
}
__device__ __forceinline__ void st_transposed(LAS bf16_t* dst, const f32x4 c, int mi, int ni, int fr, int fq) {
    u32x2 w; w.x = cvt_pk_bf16(c[0], c[1]); w.y = cvt_pk_bf16(c[2], c[3]);
    *(LAS u32x2*)(dst + (ni * 16 + fr) * MS + mi * 16 + fq * 4) = w;
}
}

__device__ __forceinline__ void wkv_chunk_phase(LAS unsigned char* lds, bf16_t* R, const bf16_t* KP, bf16_t* KK, bf16_t* BS, bf16_t* EW,
                                                const bf16_t* V, bf16_t* Y, float* WLG, const float* k_k, const float* k_a, const float* r_k, float* RK) {
    using namespace wk;
    const int tid = otid(), wid = __builtin_amdgcn_readfirstlane(tid >> 6), lane = tid & 63, fr = lane & 15, fq = lane >> 4;
    const int mi = wid >> 1, ni0 = (wid & 1) * 2;
    const int lt = tid >> 3, lk = (tid & 7) * 8;
    LAS float* CW = (LAS float*)(lds + CW_OFF); LAS float* BTOT = (LAS float*)(lds + BT_OFF);
    const f32x4 zero4 = (f32x4){0.f, 0.f, 0.f, 0.f};
    const int G = gridDim.x;
    int u = blockIdx.x;
    u32x4 g_ew, g_bs, g_kp, g_r, g_v; f32x4 g_c[6];
    g_ew = g_bs = g_kp = g_r = g_v = (u32x4){0u, 0u, 0u, 0u};
#pragma unroll
    for (int i = 0; i < 6; ++i) g_c[i] = (f32x4){0.f, 0.f, 0.f, 0.f};
    if (u < 4096) { const int head = u & 63, chunk = u >> 6; const size_t base = ((size_t)(head >> 4) * SEQ + chunk * 64 + lt) * D + (head & 15) * 64 + lk;
        g_ew = *(const u32x4*)(EW + base); g_bs = *(const u32x4*)(BS + base); g_kp = *(const u32x4*)(KP + base); g_r = *(const u32x4*)(R + base); g_v = *(const u32x4*)(V + base);
        const int co = (head & 15) * 64 + lk; g_c[0] = *(const f32x4*)(k_k + co); g_c[1] = *(const f32x4*)(k_k + co + 4); g_c[2] = *(const f32x4*)(k_a + co); g_c[3] = *(const f32x4*)(k_a + co + 4); g_c[4] = *(const f32x4*)(r_k + co); g_c[5] = *(const f32x4*)(r_k + co + 4); }
    for (; u < 4096; u += G) {
        const int head = u & 63, chunk = u >> 6, h = head & 15;
        const size_t tok0 = (size_t)(head >> 4) * SEQ + (size_t)chunk * 64;
        float ew[8];
        ew[0] = bflo(g_ew.x); ew[1] = bfhi(g_ew.x); ew[2] = bflo(g_ew.y); ew[3] = bfhi(g_ew.y); ew[4] = bflo(g_ew.z); ew[5] = bfhi(g_ew.z); ew[6] = bflo(g_ew.w); ew[7] = bfhi(g_ew.w);
        *(LAS f32x4*)(CW + lt * 64 + lk) = (f32x4){ew[0], ew[1], ew[2], ew[3]}; *(LAS f32x4*)(CW + lt * 64 + lk + 4) = (f32x4){ew[4], ew[5], ew[6], ew[7]};
        const u32x4 c_bs = g_bs, c_kp = g_kp, c_r = g_r, c_v = g_v;
        const f32x4 kka = g_c[0], kkb = g_c[1], kaa = g_c[2], kab = g_c[3], rka = g_c[4], rkb = g_c[5];
        if (u + G < 4096) { const int u2 = u + G, head2 = u2 & 63, chunk2 = u2 >> 6; const size_t nb = ((size_t)(head2 >> 4) * SEQ + chunk2 * 64 + lt) * D + (head2 & 15) * 64 + lk;
            g_ew = *(const u32x4*)(EW + nb); g_bs = *(const u32x4*)(BS + nb); g_kp = *(const u32x4*)(KP + nb); g_r = *(const u32x4*)(R + nb); g_v = *(const u32x4*)(V + nb);
            const int co = (head2 & 15) * 64 + lk; g_c[0] = *(const f32x4*)(k_k + co); g_c[1] = *(const f32x4*)(k_k + co + 4); g_c[2] = *(const f32x4*)(k_a + co); g_c[3] = *(const f32x4*)(k_a + co + 4); g_c[4] = *(const f32x4*)(r_k + co); g_c[5] = *(const f32x4*)(r_k + co + 4); }
        float kk[8], bs[8], kp[8], rr[8];
        { const float kr_[8] = {bflo(c_kp.x), bfhi(c_kp.x), bflo(c_kp.y), bfhi(c_kp.y), bflo(c_kp.z), bfhi(c_kp.z), bflo(c_kp.w), bfhi(c_kp.w)};
          const float aa[8] = {bflo(c_bs.x), bfhi(c_bs.x), bflo(c_bs.y), bfhi(c_bs.y), bflo(c_bs.z), bfhi(c_bs.z), bflo(c_bs.w), bfhi(c_bs.w)};
          const float r8[8] = {bflo(c_r.x), bfhi(c_r.x), bflo(c_r.y), bfhi(c_r.y), bflo(c_r.z), bfhi(c_r.z), bflo(c_r.w), bfhi(c_r.w)};
          const float ck[8] = {kka[0], kka[1], kka[2], kka[3], kkb[0], kkb[1], kkb[2], kkb[3]}, ca[8] = {kaa[0], kaa[1], kaa[2], kaa[3], kab[0], kab[1], kab[2], kab[3]}, cr[8] = {rka[0], rka[1], rka[2], rka[3], rkb[0], rkb[1], rkb[2], rkb[3]};
          float ss = 0.f, rk = 0.f;
#pragma unroll
          for (int j = 0; j < 8; ++j) { kk[j] = kr_[j] * ck[j]; ss += kk[j] * kk[j]; kp[j] = rbf(kr_[j] * (1.0f + (aa[j] - 1.0f) * ca[j])); rr[j] = r8[j]; rk += r8[j] * kp[j] * cr[j]; }
          ss += dppf<0xB1>(ss); ss += dppf<0x4E>(ss); ss += dppf<0x141>(ss);
          rk += dppf<0xB1>(rk); rk += dppf<0x4E>(rk); rk += dppf<0x141>(rk);
          const float inv = 1.0f / fmaxf(sqrtf(ss), 1e-12f);
#pragma unroll
          for (int j = 0; j < 8; ++j) { kk[j] = rbf(kk[j] * inv); bs[j] = rbf(kk[j] * aa[j]); }
          if ((tid & 7) == 0) RK[(tok0 + lt) * 16 + h] = rk; }
        __syncthreads();
        { const int k = tid & 63, blk = tid >> 6; float run = 0.f, pre[8];
#pragma unroll
          for (int j = 0; j < 8; ++j) { run += CW[(blk * 8 + j) * 64 + k]; pre[j] = run; }
          BTOT[blk * 64 + k] = run;
          __syncthreads();
          float off = 0.f;
#pragma unroll
          for (int bb = 0; bb < 7; ++bb) off += (bb < blk) ? BTOT[bb * 64 + k] : 0.f;
#pragma unroll
          for (int j = 0; j < 8; ++j) CW[(blk * 8 + j) * 64 + k] = off + pre[j];
        }
        __syncthreads();
        { const f32x4 cwa = *(const LAS f32x4*)(CW + lt * 64 + lk), cwb = *(const LAS f32x4*)(CW + lt * 64 + lk + 4);
          const f32x4 cla = *(const LAS f32x4*)(CW + 63 * 64 + lk), clb = *(const LAS f32x4*)(CW + 63 * 64 + lk + 4);
          float cw[8] = {cwa[0], cwa[1], cwa[2], cwa[3], cwb[0], cwb[1], cwb[2], cwb[3]}, cl[8] = {cla[0], cla[1], cla[2], cla[3], clb[0], clb[1], clb[2], clb[3]};
          float at_[8], rt_[8], bt_[8], kt_[8], bd_[8], kd_[8];
          if (lt == 63) { float* wp = WLG + ((size_t)head * 64 + chunk) * 64 + lk;
#pragma unroll
              for (int j = 0; j < 8; ++j) wp[j] = __expf(-cl[j]); }
#pragma unroll
          for (int j = 0; j < 8; ++j) { const float e1 = __expf(-cw[j]), e0 = __expf(ew[j] - cw[j]), ep = __expf(cw[j]), ed = __expf(cw[j] - cl[j]);
              at_[j] = -kk[j] * e0; rt_[j] = rr[j] * e1; bt_[j] = bs[j] * ep; kt_[j] = kp[j] * ep; bd_[j] = bs[j] * ed; kd_[j] = kp[j] * ed; }
#define PK8(a) ((u32x4){cvt_pk_bf16(a[0], a[1]), cvt_pk_bf16(a[2], a[3]), cvt_pk_bf16(a[4], a[5]), cvt_pk_bf16(a[6], a[7])})
          const u32x4 pat = PK8(at_), pbd = PK8(bd_), pkd = PK8(kd_);
          *(LAS u32x4*)(mat(lds, AT) + lt * MS + lk) = pat; *(LAS u32x4*)(mat(lds, RT) + lt * MS + lk) = PK8(rt_);
          *(LAS u32x4*)(mat(lds, BT_) + lt * MS + lk) = PK8(bt_); *(LAS u32x4*)(mat(lds, KT_) + lt * MS + lk) = PK8(kt_);
#undef PK8
#define TR8(dstm, VAL_) do { const u32x4 v_ = (VAL_); LAS bf16_t* q_ = mat(lds, dstm) + lk * MS + lt; q_[0] = (bf16_t)(v_.x & 0xffffu); q_[MS] = (bf16_t)(v_.x >> 16); q_[2 * MS] = (bf16_t)(v_.y & 0xffffu); q_[3 * MS] = (bf16_t)(v_.y >> 16); \
              q_[4 * MS] = (bf16_t)(v_.z & 0xffffu); q_[5 * MS] = (bf16_t)(v_.z >> 16); q_[6 * MS] = (bf16_t)(v_.w & 0xffffu); q_[7 * MS] = (bf16_t)(v_.w >> 16); } while (0)
          TR8(BDT, pbd); TR8(KDT, pkd); TR8(VT, c_v); TR8(SB, ((u32x4){cvt_pk_f16(at_[0], at_[1]), cvt_pk_f16(at_[2], at_[3]), cvt_pk_f16(at_[4], at_[5]), cvt_pk_f16(at_[6], at_[7])}));
#undef TR8
        }
        __syncthreads();
        f32x4 Treg[2];
        { f32x4 gab[2] = {zero4, zero4}, gak[2] = {zero4, zero4}, grb[2] = {zero4, zero4}, grk[2] = {zero4, zero4};
          mm2(gab, mat(lds, BT_), mat(lds, AT), mi, ni0, fr, fq); mm2(gak, mat(lds, KT_), mat(lds, AT), mi, ni0, fr, fq);
          mm2(grb, mat(lds, BT_), mat(lds, RT), mi, ni0, fr, fq); mm2(grk, mat(lds, KT_), mat(lds, RT), mi, ni0, fr, fq);
#pragma unroll
          for (int n = 0; n < 2; ++n) { const int t = (ni0 + n) * 16 + fr;
#pragma unroll
              for (int j = 0; j < 4; ++j) { const int i = mi * 16 + fq * 4 + j;
                  gab[n][j] = (i < t) ? gab[n][j] : 0.f; gak[n][j] = (i < t) ? gak[n][j] : 0.f; grb[n][j] = (i <= t) ? grb[n][j] : 0.f; grk[n][j] = (i <= t) ? grk[n][j] : 0.f;
                  Treg[n][j] = gab[n][j] + ((i == t) ? 1.f : 0.f); } }
#pragma unroll
          for (int n = 0; n < 2; ++n) { const int ni = ni0 + n;
              st_rowmajor_h(mat(lds, PA), gab[n], mi, ni, fr, fq); st_transposed_h(mat(lds, PB), gab[n], mi, ni, fr, fq); st_rowmajor_h(mat(lds, TA), Treg[n], mi, ni, fr, fq);
              st_transposed(mat(lds, MAKT), gak[n], mi, ni, fr, fq); st_transposed(mat(lds, MRBT), grb[n], mi, ni, fr, fq); st_transposed(mat(lds, MRKT), grk[n], mi, ni, fr, fq); }
        }
        __syncthreads();
#pragma unroll
        for (int st = 1; st <= 6; ++st) {
            LAS bf16_t* Pa = mat(lds, ((st - 1) & 1) ? BT_ : PA); LAS bf16_t* Pb = mat(lds, ((st - 1) & 1) ? KT_ : PB);
            if (st <= 5) { LAS bf16_t* Na = mat(lds, (st & 1) ? BT_ : PA); LAS bf16_t* Nb = mat(lds, (st & 1) ? KT_ : PB);
                f32x4 pw[2] = {zero4, zero4};
                mm2<true>(pw, Pa, Pb, mi, ni0, fr, fq);
                st_rowmajor_h(Na, pw[0], mi, ni0, fr, fq); st_rowmajor_h(Na, pw[1], mi, ni0 + 1, fr, fq);
                st_transposed_h(Nb, pw[0], mi, ni0, fr, fq); st_transposed_h(Nb, pw[1], mi, ni0 + 1, fr, fq); }
            if (st >= 2) { LAS bf16_t* Tp = mat(lds, ((st - 2) & 1) ? TB : TA);
                mm2<true>(Treg, Tp, Pb, mi, ni0, fr, fq);
                if (st < 6) { LAS bf16_t* Tn = mat(lds, ((st - 1) & 1) ? TB : TA); st_rowmajor_h(Tn, Treg[0], mi, ni0, fr, fq); st_rowmajor_h(Tn, Treg[1], mi, ni0 + 1, fr, fq); }
                else { st_transposed_h(mat(lds, TB), Treg[0], mi, ni0, fr, fq); st_transposed_h(mat(lds, TB), Treg[1], mi, ni0 + 1, fr, fq); } }
            __syncthreads();
        }
        { f32x4 a2[2] = {zero4, zero4}, x1[2] = {zero4, zero4};
          mm2<true>(a2, mat(lds, SB), mat(lds, TB), mi, ni0, fr, fq); mm2(x1, mat(lds, VT), mat(lds, MAKT), mi, ni0, fr, fq);
          st_rowmajor(mat(lds, PA), a2[0], mi, ni0, fr, fq); st_rowmajor(mat(lds, PA), a2[1], mi, ni0 + 1, fr, fq);
          st_rowmajor_h(mat(lds, PB), x1[0], mi, ni0, fr, fq); st_rowmajor_h(mat(lds, PB), x1[1], mi, ni0 + 1, fr, fq); }
        __syncthreads();
        { f32x4 xp[2] = {zero4, zero4}, r2[2], pl[2] = {zero4, zero4};
#pragma unroll
          for (int n = 0; n < 2; ++n) { const u32x2 w = *(const LAS u32x2*)(mat(lds, RT) + ((ni0 + n) * 16 + fr) * MS + mi * 16 + fq * 4); r2[n] = (f32x4){bflo(w.x), bfhi(w.x), bflo(w.y), bfhi(w.y)}; }
          mm2<true>(xp, mat(lds, PB), mat(lds, TB), mi, ni0, fr, fq); mm2(r2, mat(lds, PA), mat(lds, MRBT), mi, ni0, fr, fq); mm2(pl, mat(lds, PA), mat(lds, BDT), mi, ni0, fr, fq);
          st_rowmajor(mat(lds, BT_), xp[0], mi, ni0, fr, fq); st_rowmajor(mat(lds, BT_), xp[1], mi, ni0 + 1, fr, fq);
#pragma unroll
          for (int n = 0; n < 2; ++n) { const size_t o = (tok0 + (ni0 + n) * 16 + fr) * D + h * 64 + mi * 16 + fq * 4; st_h4(BS + o, r2[n]); st_h4(EW + o, pl[n]); } }
        __syncthreads();
        { f32x4 y0[2] = {zero4, zero4}, qq[2] = {zero4, zero4};
          mm2(y0, mat(lds, BT_), mat(lds, MRBT), mi, ni0, fr, fq); mm2(y0, mat(lds, VT), mat(lds, MRKT), mi, ni0, fr, fq);
          mm2(qq, mat(lds, BT_), mat(lds, BDT), mi, ni0, fr, fq); mm2(qq, mat(lds, VT), mat(lds, KDT), mi, ni0, fr, fq);
#pragma unroll
          for (int n = 0; n < 2; ++n) { const size_t o = (tok0 + (ni0 + n) * 16 + fr) * D + h * 64 + mi * 16 + fq * 4;
              st_h4(Y + o, y0[n]);
              st_h4(KK + o, qq[n]); } }
        __syncthreads();
    }
}

__device__ __forceinline__ void wkv_state_phase(LAS unsigned char* lds, const bf16_t* PLT, const bf16_t* QT, const float* WLG, bf16_t* SC) {
    using namespace wk;
    constexpr int PF = 8;
    const int tid = otid(), wid = __builtin_amdgcn_readfirstlane(tid >> 6), lane = tid & 63, fr = lane & 15, fq = lane >> 4;
    const bool act = wid < 4; const int ni = wid & 3;
    for (int unit = blockIdx.x; unit < 256; unit += gridDim.x) {
        const int head = unit >> 2, qv = unit & 3, b = head >> 4, h = head & 15;
        f32x4 S = (f32x4){0.f, 0.f, 0.f, 0.f};
        u32x4 rb0[PF], rb1[PF]; u32x2 rq[PF]; float rw[PF];
        const size_t obase = ((size_t)b * SEQ + ni * 16 + fr) * D + h * 64;
        const float* wbase = WLG + ((size_t)head * 64) * 64 + ni * 16 + fr;
#pragma unroll
        for (int i = 0; i < PF; ++i) { rb0[i] = rb1[i] = (u32x4){0u, 0u, 0u, 0u}; rq[i] = (u32x2){0u, 0u}; rw[i] = 0.f;
            { const size_t o = obase + (size_t)i * 64 * D; rb0[i] = *(const u32x4*)(PLT + o + fq * 8); rb1[i] = *(const u32x4*)(PLT + o + 32 + fq * 8); rq[i] = *(const u32x2*)(QT + o + qv * 16 + fq * 4); rw[i] = wbase[i * 64]; } }
#define SB_STEP(i) do { \
                const int c = c0 + (i); \
                const size_t tok0 = (size_t)b * SEQ + (size_t)c * 64; \
                LAS bf16_t* buf = (LAS bf16_t*)(lds + ((i) & 1) * 16 * MS * 2); \
                const u32x4 b0 = rb0[i], b1 = rb1[i]; const u32x2 cq = rq[i]; const float wl = rw[i]; \
                if (act) { const unsigned lo = cvt_pk_f16(S[0], S[1]), hi = cvt_pk_f16(S[2], S[3]); LAS bf16_t* p = buf + (fq * 4) * MS + ni * 16 + fr; \
                    p[0] = (bf16_t)(lo & 0xffffu); p[MS] = (bf16_t)(lo >> 16); p[2 * MS] = (bf16_t)(hi & 0xffffu); p[3 * MS] = (bf16_t)(hi >> 16); } \
                    { const int cn = (c + PF < 64) ? c + PF : 63; const size_t o = obase + (size_t)cn * 64 * D;        \
                        rb0[i] = *(const u32x4*)(PLT + o + fq * 8); rb1[i] = *(const u32x4*)(PLT + o + 32 + fq * 8); rq[i] = *(const u32x2*)(QT + o + qv * 16 + fq * 4); rw[i] = wbase[cn * 64]; } \
                __syncthreads(); \
                if (tid >= 256 && tid < 384) { const int row = (tid >> 3) & 15, pc = tid & 7; \
                    *(u32x4*)(SC + (tok0 + qv * 16 + row) * D + h * 64 + pc * 8) = *(const LAS u32x4*)(buf + row * MS + pc * 8); } \
                if (act) { const bf16x8 a0 = *(const LAS bf16x8*)(buf + fr * MS + fq * 8), a1 = *(const LAS bf16x8*)(buf + fr * MS + 32 + fq * 8); \
                    const f32x2 q01 = unpk_f16(cq.x), q23 = unpk_f16(cq.y); \
                    f32x4 acc = S * wl + (f32x4){q01.x, q01.y, q23.x, q23.y}; \
                    acc = __builtin_amdgcn_mfma_f32_16x16x32_f16(__builtin_bit_cast(f16x8, a0), __builtin_bit_cast(f16x8, b0), acc, 0, 0, 0); \
                    acc = __builtin_amdgcn_mfma_f32_16x16x32_f16(__builtin_bit_cast(f16x8, a1), __builtin_bit_cast(f16x8, b1), acc, 0, 0, 0); \
                    S = acc; } } while (0)
#define SB_STEP8(c0_) do { const int c0 = (c0_); SB_STEP(0); SB_STEP(1); SB_STEP(2); SB_STEP(3); SB_STEP(4); SB_STEP(5); SB_STEP(6); SB_STEP(7); } while (0)
        SB_STEP8(0); SB_STEP8(8); SB_STEP8(16); SB_STEP8(24); SB_STEP8(32); SB_STEP8(40); SB_STEP8(48); SB_STEP8(56);
#undef SB_STEP8
#undef SB_STEP
        __syncthreads();
    }
}

__device__ __forceinline__ void wkv_out_phase(const bf16_t* SC, const bf16_t* R2T, const bf16_t* Y0L, bf16_t* Y,
                                              const bf16_t* V, const bf16_t* Gt, const float* RK, const float* ln_w, const float* ln_b) {
    const int tid = otid(), wid = __builtin_amdgcn_readfirstlane(tid >> 6), lane = tid & 63, fr = lane & 15, fq = lane >> 4;
    const int ni = wid & 3, grp = wid >> 2;
    const int G = gridDim.x;
    for (int u = blockIdx.x + grp * G; u < 4096; u += 2 * G) {
        const int head = u & 63, chunk = u >> 6, h = head & 15;
        const size_t tok0 = (size_t)(head >> 4) * SEQ + (size_t)chunk * 64;
        const size_t trow = (tok0 + ni * 16 + fr) * D + h * 64;
        const bf16x8 b0 = *(const bf16x8*)(R2T + trow + fq * 8), b1 = *(const bf16x8*)(R2T + trow + 32 + fq * 8);
        bf16x8 a0[4], a1[4]; f32x4 acc[4]; u32x2 vv[4], gg[4]; f32x4 lw[4], lb[4];
#pragma unroll
        for (int mi = 0; mi < 4; ++mi) { const bf16_t* ap = SC + (tok0 + mi * 16 + fr) * D + h * 64 + fq * 8;
            a0[mi] = *(const bf16x8*)ap; a1[mi] = *(const bf16x8*)(ap + 32);
            const size_t o = trow + mi * 16 + fq * 4;
            acc[mi] = ld_h4(Y + o);
            vv[mi] = *(const u32x2*)(V + o); gg[mi] = *(const u32x2*)(Gt + o);
            lw[mi] = *(const f32x4*)(ln_w + h * 64 + mi * 16 + fq * 4); lb[mi] = *(const f32x4*)(ln_b + h * 64 + mi * 16 + fq * 4); }
        const float rk = RK[(tok0 + ni * 16 + fr) * 16 + h];
        float s1 = 0.f, s2 = 0.f;
#pragma unroll
        for (int mi = 0; mi < 4; ++mi) {
            acc[mi] = __builtin_amdgcn_mfma_f32_16x16x32_f16(__builtin_bit_cast(f16x8, a0[mi]), __builtin_bit_cast(f16x8, b0), acc[mi], 0, 0, 0);
            acc[mi] = __builtin_amdgcn_mfma_f32_16x16x32_f16(__builtin_bit_cast(f16x8, a1[mi]), __builtin_bit_cast(f16x8, b1), acc[mi], 0, 0, 0); }
#pragma unroll
        for (int mi = 0; mi < 4; ++mi) { const f32x4 y = acc[mi]; s1 += (y[0] + y[1]) + (y[2] + y[3]); }
        s1 += __shfl_xor(s1, 16); s1 += __shfl_xor(s1, 32);
        const float mean = s1 * (1.0f / 64.0f);
#pragma unroll
        for (int mi = 0; mi < 4; ++mi) { const f32x4 d = acc[mi] - mean; s2 += (d[0] * d[0] + d[1] * d[1]) + (d[2] * d[2] + d[3] * d[3]); }
        s2 += __shfl_xor(s2, 16); s2 += __shfl_xor(s2, 32);
        const float rs = rsqrtf(s2 * (1.0f / 64.0f) + 64e-5f);
#pragma unroll
        for (int mi = 0; mi < 4; ++mi) {
            const f32x4 v4 = (f32x4){bflo(vv[mi].x), bfhi(vv[mi].x), bflo(vv[mi].y), bfhi(vv[mi].y)}, g4 = (f32x4){bflo(gg[mi].x), bfhi(gg[mi].x), bflo(gg[mi].y), bfhi(gg[mi].y)};
            st_bf4(Y + trow + mi * 16 + fq * 4, ((acc[mi] - mean) * rs * lw[mi] + lb[mi] + rk * v4) * g4); }
    }
}

__device__ __forceinline__ void final_phase(float* x, const float* g) {
    const int tid_ = otid(), lane = tid_ & 63, gw = blockIdx.x * 8 + (tid_ >> 6), GW = gridDim.x * 8;
    for (int tok0 = gw; tok0 < M; tok0 += 4 * GW) {
        f32x4 xv[4][4]; float ss[4] = {0.f, 0.f, 0.f, 0.f};
#pragma unroll
        for (int u = 0; u < 4; ++u) { const int tok = tok0 + u * GW; const bool ok = tok < M;
#pragma unroll
            for (int j = 0; j < 4; ++j) { xv[u][j] = ok ? *(const f32x4*)(x + (size_t)tok * D + j * 256 + lane * 4) : (f32x4){0.f, 0.f, 0.f, 0.f};
                ss[u] += xv[u][j][0] * xv[u][j][0] + xv[u][j][1] * xv[u][j][1] + xv[u][j][2] * xv[u][j][2] + xv[u][j][3] * xv[u][j][3]; } }
#pragma unroll
        for (int u = 0; u < 4; ++u) { const int tok = tok0 + u * GW; if (tok >= M) break;
            const float ri = rsqrtf(wave_sum(ss[u]) * (1.0f / D) + 1e-6f);
#pragma unroll
            for (int j = 0; j < 4; ++j) { const int c = j * 256 + lane * 4; *(f32x4*)(x + (size_t)tok * D + c) = xv[u][j] * ri * *(const f32x4*)(g + c); } }
    }
}

__device__ __forceinline__ void e0_phase(const Params& p) {
    unsigned char* ws = p.ws;
    const int tid_ = otid(), lane = tid_ & 63, gw = blockIdx.x * 8 + (tid_ >> 6), GW = gridDim.x * 8;
    const float* MOD = (const float*)(ws + WS_MOD);
    float* GG = (float*)(ws + WS_GG);
    for (int e = blockIdx.x * NTHREADS + tid_; e < 4 * 2 * NB * D; e += gridDim.x * NTHREADS) {
        const int c = e & (D - 1), b = (e >> 10) & 3, sub = (e >> 12) & 1, layer = e >> 13;
        GG[e] = p.in[2][(size_t)(layer * 2 + sub) * D + c] * (1.0f + MOD[(size_t)(layer * NB + b) * NMOD + (sub ? 4 * D : D) + c]);
    }
    for (int task = gw; task < 4 * FF + 2 * 3 * D; task += GW) {
        const bf16_t* wrow; const float* sh; float* outp; int ostride;
        if (task < 4 * FF) { const int layer = task >> 12, n = task & (FF - 1);
            wrow = (const bf16_t*)(ws + WS_W1T) + ((size_t)layer * FF + n) * D; sh = MOD + (size_t)layer * NB * NMOD + 3 * D; outp = (float*)(ws + WS_SHW1) + (size_t)layer * NB * FF + n; ostride = FF; }
        else { const int t = task - 4 * FF, j = t / (3 * D), n = t % (3 * D);
            wrow = (const bf16_t*)(ws + WS_WINT) + ((size_t)j * 3 * D + n) * D; sh = MOD + (size_t)(2 * j) * NB * NMOD; outp = (float*)(ws + WS_SHWIN) + (size_t)j * NB * 3 * D + n; ostride = 3 * D; }
        float a0 = 0.f, a1 = 0.f, a2 = 0.f, a3 = 0.f;
#pragma unroll
        for (int jj = 0; jj < 4; ++jj) { const int c = jj * 256 + lane * 4; const f32x4 w = ld_bf4(wrow + c);
            const f32x4 s0 = *(const f32x4*)(sh + c), s1 = *(const f32x4*)(sh + NMOD + c), s2 = *(const f32x4*)(sh + 2 * NMOD + c), s3 = *(const f32x4*)(sh + 3 * NMOD + c);
            a0 += w[0] * s0[0] + w[1] * s0[1] + w[2] * s0[2] + w[3] * s0[3]; a1 += w[0] * s1[0] + w[1] * s1[1] + w[2] * s1[2] + w[3] * s1[3];
            a2 += w[0] * s2[0] + w[1] * s2[1] + w[2] * s2[2] + w[3] * s2[3]; a3 += w[0] * s3[0] + w[1] * s3[1] + w[2] * s3[2] + w[3] * s3[3]; }
        a0 = wave_sum(a0); a1 = wave_sum(a1); a2 = wave_sum(a2); a3 = wave_sum(a3);
        if (lane == 0) { outp[0] = a0; outp[ostride] = a1; outp[2 * ostride] = a2; outp[3 * ostride] = a3; }
    }
}

__global__ void __launch_bounds__(NTHREADS, 2) mega_fwd(Params p) {
    extern __shared__ __attribute__((aligned(16))) unsigned char lds_raw[];
    LAS unsigned char* lds = (LAS unsigned char*)lds_raw;
    cg::grid_group grid = cg::this_grid();
    unsigned char* ws = p.ws;
    const int G = gridDim.x, cid = blockIdx.x;
    float* X = p.out;
    const float* MOD = (const float*)(ws + WS_MOD);
    bf16_t* HB = (bf16_t*)(ws + WS_HB);
    unsigned char* R0 = ws + WS_R0;
    const char* HB_A = (const char*)(ws + WS_HB) + (size_t)PADROWS * D * 2;
    const char* HB_A2 = (const char*)(ws + WS_HB) + (size_t)(PADROWS - 1) * D * 2;

    if (blockIdx.x == 0) { unsigned* bw = (unsigned*)(ws + WS_BAR); for (int i = threadIdx.x; i < XCD_BAR_WORDS; i += NTHREADS) bw[i] = 0u; }
    if (threadIdx.x < 4) ((LAS unsigned*)(lds + LDS_BAR_OFF))[threadIdx.x] = 0u;
    p0_prologue(p, lds);
    grid.sync();
    const XcdBarrier xbar = xcd_barrier_post((unsigned*)(ws + WS_BAR), (volatile LAS unsigned*)(lds + LDS_BAR_OFF));
#define GSYNC() xcd_barrier(xbar)
    float* SSQ = (float*)(ws + WS_SS);
    const float* GG = (const float*)(ws + WS_GG);
    LAS float* RINV = (LAS float*)(lds + LDS_RINV_OFF);

    for (int layer = 0; layer < 4; ++layer) {
        const int j = layer >> 1;
        const float* xin = (layer == 0) ? p.in[0] : X;
        const float* mod = MOD + (size_t)layer * NB * NMOD;
        const bf16_t* mixA; const char* mixW;
        if ((layer & 1) == 0) {
            if (layer == 0) {
                e0_phase(p);
                norm_phase<2>(xin, p.in[2], mod, mod + D, HB, nullptr, nullptr, nullptr, nullptr, SSQ);
                GSYNC();
            }
            bf16_t* BCH = (bf16_t*)R0; bf16_t* Z = (bf16_t*)(R0 + 96 * MBy);
            { pg8::Gemm g{HB_A, (const char*)(ws + WS_WINT) + (size_t)j * 3 * D * D * 2, 64, 12, D, D, 1, 1 << 20, 0, 0, 0};
              pg8::StaticOrder S; S.init(64, 12, G, cid);
              pg8::EpiBf16<0, true> E{BCH, BCH, BCH, 3 * D, 0, SSQ, (const float*)(ws + WS_SHWIN) + (size_t)j * NB * 3 * D, 3 * D, RINV};
              pg8::gemm_phase(lds, g, S, E); }
            GSYNC();
            conv_phase(BCH, p.in[7] + (size_t)j * 3 * D, Z);
            GSYNC();
            mixA = Z; mixW = (const char*)(ws + WS_WOUTT) + (size_t)j * D * D * 2;
        } else {
            bf16_t* XR = (bf16_t*)R0; bf16_t* XK = (bf16_t*)(R0 + 32 * MBy); bf16_t* XV = (bf16_t*)(R0 + 64 * MBy);
            bf16_t* RB = (bf16_t*)(R0 + 96 * MBy); bf16_t* KB = (bf16_t*)(R0 + 128 * MBy);
            bf16_t* VF = (bf16_t*)(ws + WS_VF);
            bf16_t* VB = (j == 0) ? VF : (bf16_t*)(R0 + 160 * MBy);
            bf16_t* YB = (j == 0) ? (bf16_t*)(R0 + 160 * MBy) : VF;
            bf16_t* EW = XR; bf16_t* AB = XK; bf16_t* KK = XV; bf16_t* GB = HB;
            bf16_t* MIDS = (bf16_t*)(ws + WS_MIDS);
            float* BR = (float*)(ws + WS_BR); float* RKs = (float*)(ws + WS_RK);
            norm_phase<1>(xin, p.in[2] + (size_t)(layer * 2) * D, mod, mod + D, HB, p.in[9] + (size_t)j * 6 * D, XR, XK, XV);
            GSYNC();
            { pg8::Gemm g{(const char*)XR, (const char*)(ws + WS_RKVT) + (size_t)j * 3 * D * D * 2, 64, 12, D, D, 0, 4, 32 * MBy, 64 * MBy, 0};
              pg8::StaticOrder S; S.init(64, 12, G, cid); S.skew = (G == 256) ? 1 : 0;
              pg8::EpiBf16<0> E{RB, KB, VB, D, 4, nullptr, nullptr, 0, RINV};
              pg8::gemm_phase(lds, g, S, E); }
            { pg8::Gemm g{HB_A2, (const char*)(ws + WS_L1T) + (size_t)j * 512 * 2048 * 2, 64, 2, 2048, D, 1, 1 << 20, 0, 0, 0};
              pg8::StaticOrder S; S.init(64, 2, G, cid);
              pg8::EpiBf16<2> E{MIDS, MIDS, MIDS, 512, 0, nullptr, nullptr, 0, RINV};
              pg8::gemm_phase(lds, g, S, E); }
            GSYNC();
            { const int nN = (j == 0) ? 12 : 16;
              pg8::Gemm g{(const char*)MIDS, (const char*)(ws + WS_L2T) + (size_t)j * 4096 * 256 * 2, 64, nN, 256, 512, 0, 4, 0, 128 * 2, 256 * 2};
              pg8::StaticOrder S; S.init(64, nN, G, cid);
              pg8::EpiLora2 E{EW, AB, GB, VB, VF, p.in[12] + (size_t)j * D, p.in[15] + (size_t)j * D, p.in[25]};
              pg8::gemm_phase(lds, g, S, E); }
            GSYNC();
            wkv_chunk_phase(lds, RB, KB, KK, AB, EW, VB, YB, BR, p.in[20] + (size_t)j * D, p.in[21] + (size_t)j * D, p.in[22] + (size_t)j * D, RKs);
            GSYNC();
            wkv_state_phase(lds, EW, KK, BR, KB);
            GSYNC();
            wkv_out_phase(KB, AB, RB, YB, VB, GB, RKs, p.in[23] + (size_t)j * D, p.in[24] + (size_t)j * D);
            GSYNC();
            mixA = YB; mixW = (const char*)(ws + WS_WOT) + (size_t)j * D * D * 2;
        }
        { pg8::Gemm g{(const char*)mixA, mixW, 64, 4, D, D, 0, 1 << 20, 0, 0, 0};
          pg8::StaticOrder S; S.init(64, 4, G, cid);
          pg8::EpiResid E{xin, X, mod + 2 * D, 1, HB, GG + (size_t)(layer * 2 + 1) * NB * D, SSQ};
          pg8::gemm_phase(lds, g, S, E); }
        GSYNC();
        bf16_t* HID = (bf16_t*)R0;
        { pg8::Gemm g{HB_A, (const char*)(ws + WS_W1T) + (size_t)layer * D * FF * 2, 64, 16, D, D, 1, 1 << 20, 0, 0, 0};
          pg8::StaticOrder S; S.init(64, 16, G, cid);
          pg8::EpiBf16<1, true> E{HID, HID, HID, FF, 0, SSQ, (const float*)(ws + WS_SHW1) + (size_t)layer * NB * FF, FF, RINV};
          pg8::gemm_phase(lds, g, S, E); }
        GSYNC();
        { pg8::Gemm g{(const char*)HID, (const char*)(ws + WS_W2T) + (size_t)layer * D * FF * 2, 64, 4, FF, FF, 0, 1 << 20, 0, 0, 0};
          pg8::StaticOrder S; S.init(64, 4, G, cid);
          const int emit2 = (layer == 1) ? 1 : 0;
          pg8::EpiResid E{X, X, mod + 5 * D, emit2, HB, GG + (size_t)((layer + 1) * 2 % 8) * NB * D, SSQ};
          pg8::gemm_phase(lds, g, S, E); }
        GSYNC();
    }
    final_phase(X, p.in[3]);
}

extern "C" void kernel_launch(void* const* d_in, const int* in_sizes, int n_in, void* d_out, int out_size, void* d_ws, size_t ws_size, hipStream_t stream) {
    static int grid = 0;
    if (grid == 0) {
        if (n_in != 30 || out_size != M * D || ws_size < WS_END) { fprintf(stderr, "kernel_launch: unexpected shapes (n_in %d out %d ws %zu)\n", n_in, out_size, ws_size); grid = -1; return; }
        int dev = 0, cus = 0, per_cu = 0;
        (void)hipGetDevice(&dev);
        (void)hipDeviceGetAttribute(&cus, hipDeviceAttributeMultiprocessorCount, dev);
        if (hipFuncSetAttribute((const void*)mega_fwd, hipFuncAttributeMaxDynamicSharedMemorySize, LDS_BYTES) != hipSuccess) { fprintf(stderr, "kernel_launch: hipFuncSetAttribute failed\n"); grid = -1; return; }
        if (hipOccupancyMaxActiveBlocksPerMultiprocessor(&per_cu, (const void*)mega_fwd, NTHREADS, LDS_BYTES) != hipSuccess || per_cu < 1) { fprintf(stderr, "kernel_launch: occupancy query failed (%d)\n", per_cu); grid = -1; return; }
        grid = cus;
    }
    if (grid < 0) return;
    Params p{};
    for (int i = 0; i < 30; ++i) p.in[i] = (const float*)d_in[i];
    p.out = (float*)d_out; p.ws = (unsigned char*)d_ws;
    void* args[] = {&p};
    hipError_t e = hipLaunchCooperativeKernel((const void*)mega_fwd, dim3(grid), dim3(NTHREADS), args, LDS_BYTES, stream);
    if (e != hipSuccess) fprintf(stderr, "cooperative launch failed: %s (grid %d)\n", hipGetErrorString(e), grid);
}
```

```cpp
#include <hip/hip_runtime.h>
#include <hip/hip_cooperative_groups.h>
#include <cstdio>
namespace cg = cooperative_groups;

#define LAS __attribute__((address_space(3)))
typedef unsigned short bf16_t;
typedef short bf16x8 __attribute__((ext_vector_type(8)));
typedef float f32x4 __attribute__((ext_vector_type(4)));
typedef float f32x2 __attribute__((ext_vector_type(2)));
typedef unsigned u32x4 __attribute__((ext_vector_type(4)));
typedef unsigned u32x2 __attribute__((ext_vector_type(2)));

constexpr int D = 1024, NB = 4, SEQ = 4096, M = NB * SEQ, FF = 4096, NMOD = 6 * D;
constexpr int PADROWS = 256, HROWS = SEQ + PADROWS;
constexpr int NTHREADS = 512;
constexpr int LDS_BAR_OFF = 140800;
constexpr int LDS_BYTES = LDS_BAR_OFF + 256;

constexpr size_t MBy = 1u << 20;
constexpr size_t WS_MOD = 0;
constexpr size_t WS_BR = 512 * 1024;
constexpr size_t WS_RK = WS_BR + MBy;
constexpr size_t WS_BAR = 3 * MBy;
constexpr size_t WS_GG = 3 * MBy + 64 * 1024;
constexpr size_t WS_SHW1 = 3 * MBy + 256 * 1024;
constexpr size_t WS_SHWIN = 3 * MBy + 512 * 1024;
constexpr size_t WS_W1T = 4 * MBy;
constexpr size_t WS_W2T = 36 * MBy;
constexpr size_t WS_WINT = 68 * MBy;
constexpr size_t WS_WOUTT = 80 * MBy;
constexpr size_t WS_RKVT = 84 * MBy;
constexpr size_t WS_WOT = 96 * MBy;
constexpr size_t WS_L1T = 100 * MBy;
constexpr size_t WS_L2T = 104 * MBy;
constexpr size_t WS_HB = 108 * MBy;
constexpr size_t WS_MIDS = 142 * MBy;
constexpr size_t WS_VF = 158 * MBy;
constexpr size_t WS_R0 = 190 * MBy;
constexpr size_t WS_SS = 382 * MBy;
constexpr size_t WS_END = 383 * MBy;
constexpr int LDS_RINV_OFF = 131072;

struct Params { const float* in[30]; float* out; unsigned char* ws; };

typedef __bf16 bf16v2_t __attribute__((ext_vector_type(2)));
__device__ __forceinline__ unsigned cvt_pk_bf16(float lo, float hi) { const f32x2 v = (f32x2){lo, hi}; return __builtin_bit_cast(unsigned, __builtin_convertvector(v, bf16v2_t)); }
typedef _Float16 f16v2_t __attribute__((ext_vector_type(2)));
typedef _Float16 f16x8 __attribute__((ext_vector_type(8)));
__device__ __forceinline__ unsigned cvt_pk_f16(float lo, float hi) { const f32x2 v = (f32x2){lo, hi}; return __builtin_bit_cast(unsigned, __builtin_convertvector(v, f16v2_t)); }
__device__ __forceinline__ f32x2 unpk_f16(unsigned w) { return __builtin_convertvector(__builtin_bit_cast(f16v2_t, w), f32x2); }
__device__ __forceinline__ float bflo(unsigned v) { return __uint_as_float(v << 16); }
__device__ __forceinline__ float bfhi(unsigned v) { return __uint_as_float(v & 0xffff0000u); }
__device__ __forceinline__ float rbf(float x) { unsigned u = __float_as_uint(x); u += 0x7FFFu + ((u >> 16) & 1u); return __uint_as_float(u & 0xffff0000u); }
__device__ __forceinline__ f32x4 ld_bf4(const bf16_t* p) { const u32x2 v = *(const u32x2*)p; return (f32x4){bflo(v.x), bfhi(v.x), bflo(v.y), bfhi(v.y)}; }
__device__ __forceinline__ f32x4 ld_h4(const bf16_t* p) { const u32x2 v = *(const u32x2*)p; const f32x2 a = unpk_f16(v.x), b = unpk_f16(v.y); return (f32x4){a.x, a.y, b.x, b.y}; }
__device__ __forceinline__ void st_h4(bf16_t* p, f32x4 v) { u32x2 o; o.x = cvt_pk_f16(v[0], v[1]); o.y = cvt_pk_f16(v[2], v[3]); *(u32x2*)p = o; }
__device__ __forceinline__ void st_bf4(bf16_t* p, f32x4 v) { u32x2 o; o.x = cvt_pk_bf16(v[0], v[1]); o.y = cvt_pk_bf16(v[2], v[3]); *(u32x2*)p = o; }
__device__ __forceinline__ int opq(int v) { asm volatile("" : "+s"(v)); return v; }
__device__ __forceinline__ int otid() { int t = threadIdx.x; asm volatile("" : "+v"(t)); return t; }
__device__ __forceinline__ float sigmoidf_(float x) { return 1.0f / (1.0f + __expf(-x)); }
__device__ __forceinline__ float tanhf_(float x) { return 1.0f - 2.0f / (__expf(2.0f * x) + 1.0f); }
__device__ __forceinline__ float wave_sum(float v) {
#pragma unroll
    for (int o = 32; o >= 1; o >>= 1) v += __shfl_xor(v, o);
    return v;
}
template <int CTRL> __device__ __forceinline__ float dppf(float x) { return __builtin_bit_cast(float, __builtin_amdgcn_mov_dpp(__builtin_bit_cast(int, x), CTRL, 0xf, 0xf, true)); }
__device__ __forceinline__ float row16_sum(float v) {
    v += dppf<0x128>(v); v += dppf<0x124>(v); v += dppf<0x122>(v); v += dppf<0x121>(v); return v;
}

#define XB_TMO      128
#define XB_XCNT(j)  (256  + 64 * (j))
#define XB_XSUB(j)  (1280 + 64 * (j))
#define XB_XGEN(j)  (2304 + 64 * (j))
#define XB_TOP      3328
#define XB_TOPGEN   3392
#define XCD_BAR_WORDS 3456
#define XB_SPIN_CAP (1u << 22)
__device__ __forceinline__ unsigned xb_ld(unsigned* p)              { return __hip_atomic_load(p, __ATOMIC_RELAXED, __HIP_MEMORY_SCOPE_AGENT); }
__device__ __forceinline__ unsigned xb_add(unsigned* p, unsigned v) { return __hip_atomic_fetch_add(p, v, __ATOMIC_RELAXED, __HIP_MEMORY_SCOPE_AGENT); }
__device__ __forceinline__ unsigned xb_xcc_id() { return (unsigned)__builtin_amdgcn_s_getreg((3 << 11) | 20) & 0xFu; }
#define XB_SPIN(cond, bar) do { unsigned _sp = 0; while (cond) { __builtin_amdgcn_s_sleep(1); \
    if ((++_sp & 255u) == 0u) { if (xb_ld(&(bar)[XB_TMO])) break; if (_sp > XB_SPIN_CAP) { atomicAdd(&(bar)[XB_TMO], 1u); break; } } } } while (0)
struct XcdBarrier { unsigned* bar; unsigned x; volatile LAS unsigned* st; };
__device__ __forceinline__ XcdBarrier xcd_barrier_post(unsigned* bar, volatile LAS unsigned* st) {
    XcdBarrier b; b.bar = bar; b.x = xb_xcc_id(); b.st = st;
    if (threadIdx.x == 0) (void)xb_add(&bar[XB_XCNT(b.x)], 1u);
    return b;
}
__device__ __forceinline__ void xcd_barrier_complete(unsigned* bar, unsigned x, unsigned& nloc, unsigned& nx) {
    const unsigned G = gridDim.x * gridDim.y * gridDim.z;
    unsigned sum, cnt, mine, sp = 0u;
    for (;;) {
        sum = 0u; cnt = 0u; mine = 0u;
#pragma unroll
        for (unsigned j = 0; j < 16; ++j) { const unsigned c = xb_ld(&bar[XB_XCNT(j)]); sum += c; cnt += (c > 0u) ? 1u : 0u; mine = (j == x) ? c : mine; }
        if (sum == G) break;
        __builtin_amdgcn_s_sleep(1);
        if ((++sp & 255u) == 0u) { if (xb_ld(&bar[XB_TMO])) break; if (sp > XB_SPIN_CAP) { atomicAdd(&bar[XB_TMO], 1u); break; } }
    }
    nloc = mine > 0u ? mine : 1u; nx = cnt > 0u ? cnt : 1u;
}
__device__ __forceinline__ void xcd_barrier(const XcdBarrier& b) {
    asm volatile("s_waitcnt vmcnt(0)" ::: "memory");
    __syncthreads();
    if (threadIdx.x == 0) {
        unsigned* bar = b.bar;
        const unsigned bx = (unsigned)opq((int)xb_xcc_id());
        __builtin_amdgcn_s_waitcnt(0);
        unsigned nloc = b.st[0], nx = b.st[1];
        if (nloc == 0u) { xcd_barrier_complete(bar, bx, nloc, nx); b.st[0] = nloc; b.st[1] = nx; }
        const unsigned old = xb_add(&bar[XB_XSUB(bx)], 1u);
        const unsigned gen = old / nloc;
        if (old + 1u == (gen + 1u) * nloc) {
            __builtin_amdgcn_fence(__ATOMIC_RELEASE, "agent");
            asm volatile("s_waitcnt vmcnt(0)" ::: "memory");
            const unsigned og = xb_add(&bar[XB_TOP], 1u);
            const unsigned tg = og / nx;
            if (og + 1u == (tg + 1u) * nx) xb_add(&bar[XB_TOPGEN], 1u);
            else XB_SPIN(xb_ld(&bar[XB_TOPGEN]) == tg, bar);
            __builtin_amdgcn_fence(__ATOMIC_ACQUIRE, "agent");
            xb_add(&bar[XB_XGEN(bx)], 1u);
            asm volatile("s_waitcnt vmcnt(0)" ::: "memory");
        } else {
            XB_SPIN(xb_ld(&bar[XB_XGEN(bx)]) == gen, bar);
            __builtin_amdgcn_fence(__ATOMIC_ACQUIRE, "agent");
            asm volatile("s_waitcnt vmcnt(0)" ::: "memory");
        }
    }
    __syncthreads();
}

namespace pg8 {
constexpr int BM = 256, BK = 64, HALF = 128, HTB = HALF * BK * 2, NXCD = 8, WGM = 8;
__host__ __device__ __forceinline__ int lds_byte(int r, int c) { const int st = (r >> 4) * 2 + (c >> 5), rr = r & 15, cc = c & 31, ob = rr * 64 + cc * 2; return st * 1024 + (ob ^ (((ob >> 9) & 1) << 5)); }
__host__ __device__ __forceinline__ void stage_rc(int b, int& R, int& C) { const int st = b / 1024, sb = b % 1024, swz = sb ^ (((sb >> 9) & 1) << 5); R = (st >> 1) * 16 + swz / 64; C = (st & 1) * 32 + (swz % 64) / 2; }
__host__ __device__ __forceinline__ int perm32(int rho) { const int n = rho >> 4, i = rho & 15; return 8 * (i >> 2) + 4 * n + (i & 3); }

struct Unit { int pm, pn; };
struct Gemm { const char* A; const char* Bt; int nM, nN, K, lda; int pad16; int agrp; size_t go1, go2, go3; };

struct StaticOrder {
    int nM, nN, nwg, G, c, skew;
    __device__ void init(int nM_, int nN_, int G_, int c_) { nM = nM_; nN = nN_; nwg = nM * nN; G = G_; c = c_; skew = 0; }
    __device__ bool next(int i, Unit& u) const {
        long L = (long)i * G + c;
        if (skew) { if (c >= 128) { if (i >= 4) return false; L = 4 * (c - 128) + i; } else { if (i >= 2) return false; L = 512 + 2 * c + i; } }
        if (L >= nwg) return false;
        int wgid = (int)L; { const int q = nwg / NXCD, r = nwg % NXCD, xcd = wgid % NXCD, off = wgid / NXCD; wgid = (xcd < r ? xcd * (q + 1) : r * (q + 1) + (xcd - r) * q) + off; }
        const int nig = WGM * nN, gid = wgid / nig, fm = gid * WGM, gsz = (nM - fm) < WGM ? (nM - fm) : WGM;
        u.pm = fm + ((wgid % nig) % gsz); u.pn = (wgid % nig) / gsz; return true;
    }
};

template <class Epi>
__device__ __forceinline__ void gemm_phase(LAS unsigned char* lds, const Gemm g, const StaticOrder& S, const Epi& E) {
    const int tid = otid(), wid = __builtin_amdgcn_readfirstlane(tid >> 6), lane = tid & 63, wr = wid >> 2, wc = wid & 3, fr = lane & 15, fq = lane >> 4;
    const int K = g.K, nt = K / BK, lda = g.lda;
    unsigned voffA[2], voffB[2];
#pragma unroll
    for (int i = 0; i < 2; ++i) { int R, C; stage_rc(tid * 16 + i * 8192, R, C); const int Rb = Epi::PERM ? ((R & ~31) + perm32(R & 31)) : R;
        voffA[i] = (unsigned)(R * lda + C) * 2u; voffB[i] = (unsigned)(Rb * K + C) * 2u; }
    const size_t kstep = (size_t)(BK * 2);
    const size_t hstepA = (size_t)HALF * lda * 2, hstepB = (size_t)HALF * K * 2;
    const size_t tstepA = 2 * hstepA, tstepB = 2 * hstepB;
    const unsigned ldsw = (unsigned)wid * 1024u;
    const int aoff = lds_byte(wr * 64 + fr, fq * 8), boff = lds_byte(wc * 32 + fr, fq * 8);
#define PG8_SA(b, h) (((b) * 2 + (h)) * HTB)
#define PG8_SB(b, h) ((4 + (b) * 2 + (h)) * HTB)
#define PG8_STAGE(bufoff, gbase, voff) do { _Pragma("unroll") for (int _i = 0; _i < 2; ++_i) \
        __builtin_amdgcn_global_load_lds((const unsigned*)((const char*)(gbase) + (voff)[_i]), (LAS unsigned*)(lds + (bufoff) + ldsw + _i * 8192), 16, 0, 0); } while (0)
#define PG8_LDA(dst, b, h) do { _Pragma("unroll") for (int m = 0; m < 4; ++m) _Pragma("unroll") for (int k = 0; k < 2; ++k) dst[m][k] = *(const LAS bf16x8*)(lds + PG8_SA(b, h) + aoff + m * 2048 + k * 1024); } while (0)
#define PG8_LDB(dst, b, h) do { _Pragma("unroll") for (int n = 0; n < 2; ++n) _Pragma("unroll") for (int k = 0; k < 2; ++k) dst[n][k] = *(const LAS bf16x8*)(lds + PG8_SB(b, h) + boff + n * 2048 + k * 1024); } while (0)
#define PG8_MMA(ai, bj, At, Bt) do { __builtin_amdgcn_s_setprio(1); _Pragma("unroll") for (int m = 0; m < 4; ++m) _Pragma("unroll") for (int n = 0; n < 2; ++n) _Pragma("unroll") for (int k = 0; k < 2; ++k) \
        acc[ai][bj][m][n] = __builtin_amdgcn_mfma_f32_16x16x32_bf16(Bt[n][k], At[m][k], acc[ai][bj][m][n], 0, 0, 0); __builtin_amdgcn_s_setprio(0); } while (0)
#define PG8_WAIT_V(n) asm volatile("s_waitcnt vmcnt(" #n ")" ::: "memory")
#define PG8_WAIT_L(n) asm volatile("s_waitcnt lgkmcnt(" #n ")" ::: "memory")
#define PG8_BAR __builtin_amdgcn_s_barrier()
#define PG8_SCHED __builtin_amdgcn_sched_barrier(0)
#define PG8_APTR(u) (g.A + (size_t)((u).pm + (g.pad16 ? ((u).pm >> 4) : 0)) * tstepA + (((u).pn / g.agrp) == 0 ? (size_t)0 : ((u).pn / g.agrp) == 1 ? g.go1 : ((u).pn / g.agrp) == 2 ? g.go2 : g.go3))
    Unit cur, nxt; int ui = 0;
    if (!S.next(0, cur)) return;
    if constexpr (Epi::HAS_PRO) E.prologue(cur);
    f32x4 acc[2][2][4][2];
#pragma unroll
    for (int a = 0; a < 2; ++a)
#pragma unroll
        for (int b = 0; b < 2; ++b)
#pragma unroll
            for (int m = 0; m < 4; ++m)
#pragma unroll
                for (int n = 0; n < 2; ++n) acc[a][b][m][n] = (f32x4){0.f, 0.f, 0.f, 0.f};
    bf16x8 At[4][2], B0[2][2], B1[2][2];
    const char* cA = PG8_APTR(cur); const char* cB = g.Bt + (size_t)cur.pn * tstepB;
    PG8_STAGE(PG8_SB(0, 0), cB, voffB); PG8_STAGE(PG8_SB(0, 1), cB + hstepB, voffB); PG8_STAGE(PG8_SA(0, 0), cA, voffA); PG8_STAGE(PG8_SA(0, 1), cA + hstepA, voffA);
    if (wr == 1) PG8_BAR;
    PG8_WAIT_V(2); PG8_BAR;
    PG8_STAGE(PG8_SB(1, 0), cB + kstep, voffB); PG8_STAGE(PG8_SA(1, 0), cA + kstep, voffA); PG8_STAGE(PG8_SB(1, 1), cB + hstepB + kstep, voffB);
    PG8_WAIT_V(6); PG8_BAR;
    for (;;) {
        const bool has_next = S.next(ui + 1, nxt);
        const char* nA = has_next ? PG8_APTR(nxt) : cA; const char* nB = has_next ? g.Bt + (size_t)nxt.pn * tstepB : cB;
        for (int t = 0; t < nt; t += 2) {
            const bool last = (t == nt - 2);
            const char* a1 = cA + (size_t)(t + 1) * kstep;
            const char* a2 = last ? nA : cA + (size_t)(t + 2) * kstep; const char* b2 = last ? nB : cB + (size_t)(t + 2) * kstep;
            const char* a3 = a2 + kstep; const char* b3 = b2 + kstep;
            PG8_LDB(B0, 0, 0); PG8_LDB(B1, 0, 1); PG8_SCHED; PG8_LDA(At, 0, 0); PG8_STAGE(PG8_SA(1, 1), a1 + hstepA, voffA);
            PG8_WAIT_V(8); PG8_WAIT_L(0); PG8_BAR; PG8_MMA(0, 0, At, B0); PG8_MMA(0, 1, At, B1); PG8_BAR; PG8_SCHED;
            PG8_LDA(At, 0, 1); PG8_STAGE(PG8_SB(0, 0), b2, voffB); PG8_STAGE(PG8_SB(0, 1), b2 + hstepB, voffB); PG8_STAGE(PG8_SA(0, 0), a2, voffA);
            PG8_WAIT_V(8); PG8_WAIT_L(0); PG8_BAR; PG8_MMA(1, 0, At, B0); PG8_MMA(1, 1, At, B1); PG8_BAR; PG8_SCHED;
            PG8_LDB(B0, 1, 0); PG8_LDB(B1, 1, 1); PG8_SCHED; PG8_LDA(At, 1, 0); PG8_STAGE(PG8_SA(0, 1), a2 + hstepA, voffA);
            PG8_WAIT_V(8); PG8_WAIT_L(0); PG8_BAR; PG8_MMA(0, 0, At, B0); PG8_MMA(0, 1, At, B1); PG8_BAR; PG8_SCHED;
            PG8_LDA(At, 1, 1); PG8_STAGE(PG8_SB(1, 0), b3, voffB); PG8_STAGE(PG8_SB(1, 1), b3 + hstepB, voffB); PG8_STAGE(PG8_SA(1, 0), a3, voffA);
            PG8_WAIT_V(8); PG8_WAIT_L(0); PG8_BAR; PG8_MMA(1, 0, At, B0); PG8_MMA(1, 1, At, B1); PG8_BAR; PG8_SCHED;
        }
        if (wr == 0) PG8_BAR;
        E(acc, cur, wr, wc, fr, fq);
        if (!has_next) break;
#pragma unroll
        for (int a = 0; a < 2; ++a)
#pragma unroll
            for (int b = 0; b < 2; ++b)
#pragma unroll
                for (int m = 0; m < 4; ++m)
#pragma unroll
                    for (int n = 0; n < 2; ++n) acc[a][b][m][n] = (f32x4){0.f, 0.f, 0.f, 0.f};
        cur = nxt; cA = nA; cB = nB; ++ui;
        if (wr == 1) PG8_BAR;
    }
    PG8_WAIT_V(0);
    PG8_BAR;
#undef PG8_SA
#undef PG8_SB
#undef PG8_STAGE
#undef PG8_LDA
#undef PG8_LDB
#undef PG8_MMA
#undef PG8_WAIT_V
#undef PG8_WAIT_L
#undef PG8_BAR
#undef PG8_SCHED
#undef PG8_APTR
}

template <int ACT  , bool NORM = false> struct EpiBf16 {
    static constexpr bool PERM = true, HAS_PRO = NORM;
    bf16_t* O0; bf16_t* O1; bf16_t* O2; int ldc; int split;
    const float* ssq; const float* shw; int shw_ld; LAS float* rl;
    __device__ __forceinline__ void prologue(const Unit& u) const {
        if (NORM) { const int t = otid();
            if (t < 256) { const float* pp = ssq + (size_t)(u.pm * BM + t) * 16; const f32x4 q0 = *(const f32x4*)pp, q1 = *(const f32x4*)(pp + 4), q2 = *(const f32x4*)(pp + 8), q3 = *(const f32x4*)(pp + 12);
                const f32x4 q = (q0 + q1) + (q2 + q3); rl[t] = rsqrtf(((q[0] + q[1]) + (q[2] + q[3])) * (1.0f / D) + 1e-6f); }
            if (t == 256) ((LAS int*)rl)[256] = opq(u.pm); }
    }
    __device__ __forceinline__ void operator()(const f32x4 (&acc)[2][2][4][2], const Unit& u, int wr, int wc, int fr, int fq) const {
        const int row0 = u.pm * BM + wr * 64 + fr; int pn = u.pn; bf16_t* base = O0;
        if (split) { const int t = pn / split; base = (t == 0) ? O0 : (t == 1) ? O1 : O2; pn -= t * split; }
        const int col0 = pn * BM + wc * 32 + 8 * fq;
        f32x4 sv[2][2]; bool fast = true;
        if (NORM) { const float* sp = shw + (size_t)(u.pm >> 4) * shw_ld + col0; fast = (((const LAS int*)rl)[256] == u.pm);
#pragma unroll
            for (int bj = 0; bj < 2; ++bj) { sv[bj][0] = *(const f32x4*)(sp + bj * HALF); sv[bj][1] = *(const f32x4*)(sp + bj * HALF + 4); } }
#pragma unroll
        for (int ai = 0; ai < 2; ++ai)
#pragma unroll
            for (int m = 0; m < 4; ++m) { bf16_t* rowp = base + (size_t)(row0 + ai * HALF + m * 16) * ldc + col0;
                float ri = 1.f;
                if (NORM) { if (fast) ri = rl[wr * 64 + fr + ai * HALF + m * 16];
                    else { const float* pp = ssq + (size_t)(row0 + ai * HALF + m * 16) * 16; const f32x4 q0 = *(const f32x4*)pp, q1 = *(const f32x4*)(pp + 4), q2 = *(const f32x4*)(pp + 8), q3 = *(const f32x4*)(pp + 12);
                        const f32x4 q = (q0 + q1) + (q2 + q3); ri = rsqrtf(((q[0] + q[1]) + (q[2] + q[3])) * (1.0f / D) + 1e-6f); } }
#pragma unroll
                for (int bj = 0; bj < 2; ++bj) { f32x4 v0 = acc[ai][bj][m][0], v1 = acc[ai][bj][m][1];
                    if (NORM) { v0 = v0 * ri + sv[bj][0]; v1 = v1 * ri + sv[bj][1]; }
                    if (ACT == 1) {
#pragma unroll
                        for (int j = 0; j < 4; ++j) { const float a = fmaxf(v0[j], 0.f), b = fmaxf(v1[j], 0.f); v0[j] = a * a; v1[j] = b * b; } }
                    if (ACT == 2) { const int c4 = col0 + bj * HALF;
                        if (c4 < 64) {
#pragma unroll
                            for (int j = 0; j < 4; ++j) { v0[j] = tanhf_(v0[j]); v1[j] = tanhf_(v1[j]); } }
                        else if (c4 >= 128 && c4 < 288) {
#pragma unroll
                            for (int j = 0; j < 4; ++j) { v0[j] = sigmoidf_(v0[j]); v1[j] = sigmoidf_(v1[j]); } } }
                    u32x4 w; w.x = cvt_pk_bf16(v0[0], v0[1]); w.y = cvt_pk_bf16(v0[2], v0[3]); w.z = cvt_pk_bf16(v1[0], v1[1]); w.w = cvt_pk_bf16(v1[2], v1[3]);
                    *(u32x4*)(rowp + bj * HALF) = w; } }
    }
};
struct EpiResid {
    static constexpr bool PERM = false, HAS_PRO = false;
    const float* src; float* dst; const float* gate;
    int emit; bf16_t* HBo; const float* gg; float* ssq;
    __device__ __forceinline__ void operator()(const f32x4 (&acc)[2][2][4][2], const Unit& u, int wr, int wc, int fr, int fq) const {
        const int row0 = u.pm * BM + wr * 64 + fr, col0 = u.pn * BM + wc * 32 + 4 * fq, b = u.pm >> 4;
        const float* gp = gate + (size_t)b * NMOD + col0;
        f32x4 gv[2][2], g2[2][2];
#pragma unroll
        for (int bj = 0; bj < 2; ++bj)
#pragma unroll
            for (int n = 0; n < 2; ++n) { gv[bj][n] = *(const f32x4*)(gp + bj * HALF + n * 16); g2[bj][n] = emit ? *(const f32x4*)(gg + (size_t)b * D + col0 + bj * HALF + n * 16) : (f32x4){0.f, 0.f, 0.f, 0.f}; }
#pragma unroll
        for (int ai = 0; ai < 2; ++ai)
#pragma unroll
            for (int m = 0; m < 4; ++m) { const int row = row0 + ai * HALF + m * 16; const size_t off = (size_t)row * D + col0;
                const size_t hoff = (size_t)(b * HROWS + PADROWS + (row & (SEQ - 1))) * D + col0; float ss = 0.f;
#pragma unroll
                for (int bj = 0; bj < 2; ++bj)
#pragma unroll
                    for (int n = 0; n < 2; ++n) { const f32x4 s = *(const f32x4*)(src + off + bj * HALF + n * 16);
                        const f32x4 xn = s + gv[bj][n] * acc[ai][bj][m][n];
                        *(f32x4*)(dst + off + bj * HALF + n * 16) = xn;
                        if (emit) { ss += xn[0] * xn[0] + xn[1] * xn[1] + xn[2] * xn[2] + xn[3] * xn[3]; st_bf4(HBo + hoff + bj * HALF + n * 16, xn * g2[bj][n]); } }
                if (emit) { ss += __shfl_xor(ss, 16); ss += __shfl_xor(ss, 32); if (fq == 0) ssq[(size_t)row * 16 + u.pn * 4 + wc] = ss; } }
    }
};
struct EpiLora2 {
    static constexpr bool PERM = true, HAS_PRO = false;
    bf16_t* EW; bf16_t* AB; bf16_t* GB; bf16_t* V; const bf16_t* VF; const float* w0; const float* a0; const float* v0;
    template <int GRP>
    __device__ __forceinline__ void body(const f32x4 (&acc)[2][2][4][2], const Unit& u, int wr, int wc, int fr, int fq, bf16_t* outp, const float* bias) const {
        const int row0 = u.pm * BM + wr * 64 + fr, col0 = (u.pn & 3) * BM + wc * 32 + 8 * fq;
        f32x4 bv[2][2];
#pragma unroll
        for (int bj = 0; bj < 2; ++bj)
#pragma unroll
            for (int n = 0; n < 2; ++n) bv[bj][n] = (GRP == 2) ? (f32x4){0.f, 0.f, 0.f, 0.f} : *(const f32x4*)(bias + col0 + bj * HALF + 4 * n);
#pragma unroll
        for (int ai = 0; ai < 2; ++ai)
#pragma unroll
            for (int m = 0; m < 4; ++m) { const size_t off = (size_t)(row0 + ai * HALF + m * 16) * D + col0;
#pragma unroll
                for (int bj = 0; bj < 2; ++bj) { f32x4 v0_ = acc[ai][bj][m][0] + bv[bj][0], v1_ = acc[ai][bj][m][1] + bv[bj][1];
                    if (GRP == 0) {
#pragma unroll
                        for (int j = 0; j < 4; ++j) { v0_[j] = 0.60653066f * sigmoidf_(v0_[j]); v1_[j] = 0.60653066f * sigmoidf_(v1_[j]); } }
                    else if (GRP == 1) {
#pragma unroll
                        for (int j = 0; j < 4; ++j) { v0_[j] = sigmoidf_(v0_[j]); v1_[j] = sigmoidf_(v1_[j]); } }
                    else if (GRP == 3) {
                        const u32x4 vv = *(const u32x4*)(outp + off + bj * HALF), ff = *(const u32x4*)(VF + off + bj * HALF);
                        const f32x4 va = (f32x4){bflo(vv.x), bfhi(vv.x), bflo(vv.y), bfhi(vv.y)}, vb = (f32x4){bflo(vv.z), bfhi(vv.z), bflo(vv.w), bfhi(vv.w)};
                        const f32x4 fa = (f32x4){bflo(ff.x), bfhi(ff.x), bflo(ff.y), bfhi(ff.y)}, fb = (f32x4){bflo(ff.z), bfhi(ff.z), bflo(ff.w), bfhi(ff.w)};
#pragma unroll
                        for (int j = 0; j < 4; ++j) { v0_[j] = va[j] + (fa[j] - va[j]) * sigmoidf_(v0_[j]); v1_[j] = vb[j] + (fb[j] - vb[j]) * sigmoidf_(v1_[j]); } }
                    u32x4 w; w.x = cvt_pk_bf16(v0_[0], v0_[1]); w.y = cvt_pk_bf16(v0_[2], v0_[3]); w.z = cvt_pk_bf16(v1_[0], v1_[1]); w.w = cvt_pk_bf16(v1_[2], v1_[3]);
                    *(u32x4*)(outp + off + bj * HALF) = w; } }
    }
    __device__ __forceinline__ void operator()(const f32x4 (&acc)[2][2][4][2], const Unit& u, int wr, int wc, int fr, int fq) const {
        const int grp = u.pn >> 2;
        if (grp == 0) body<0>(acc, u, wr, wc, fr, fq, EW, w0);
        else if (grp == 1) body<1>(acc, u, wr, wc, fr, fq, AB, a0);
        else if (grp == 2) body<2>(acc, u, wr, wc, fr, fq, GB, a0);
        else body<3>(acc, u, wr, wc, fr, fq, V, v0);
    }
};
}

__device__ __forceinline__ void p0_prologue(const Params& p, LAS unsigned char* lds) {
    const int tid = otid(), wid = tid >> 6, lane = tid & 63;
    unsigned char* ws = p.ws;
    LAS float* tile = (LAS float*)lds;
    LAS float* sc = (LAS float*)(lds + 69632);
    LAS float* part = (LAS float*)(lds + 69632 + 16384);
    const float* cin = p.in[1];
    for (int i = tid; i < NB * D; i += NTHREADS) { const float v = cin[i]; sc[i] = v / (1.0f + __expf(-v)); }
    __syncthreads();
    constexpr int N_GEMV = 4 * 48, N_TR = 3072;
    for (int task = blockIdx.x; task < N_GEMV + N_TR; task += gridDim.x) {
        if (task < N_GEMV) {
            const int layer = task / 48, n0 = (task % 48) * 128;
            const float* W = p.in[4] + (size_t)layer * D * NMOD + n0 + lane * 2;
            float a0x = 0.f, a0y = 0.f, a1x = 0.f, a1y = 0.f, a2x = 0.f, a2y = 0.f, a3x = 0.f, a3y = 0.f;
            const int k0 = wid * 128;
#pragma unroll 8
            for (int k = 0; k < 128; ++k) {
                const f32x2 w = *(const f32x2*)(W + (size_t)(k0 + k) * NMOD);
                const float c0 = sc[k0 + k], c1 = sc[D + k0 + k], c2 = sc[2 * D + k0 + k], c3 = sc[3 * D + k0 + k];
                a0x += c0 * w.x; a0y += c0 * w.y; a1x += c1 * w.x; a1y += c1 * w.y; a2x += c2 * w.x; a2y += c2 * w.y; a3x += c3 * w.x; a3y += c3 * w.y;
            }
            LAS float* pp = part + wid * 512 + lane * 2;
            pp[0] = a0x; pp[1] = a0y; pp[128] = a1x; pp[129] = a1y; pp[256] = a2x; pp[257] = a2y; pp[384] = a3x; pp[385] = a3y;
            __syncthreads();
            { const int b = tid >> 7, col = tid & 127; float s = 0.f;
#pragma unroll
              for (int w = 0; w < 8; ++w) s += part[w * 512 + b * 128 + col];
              ((float*)(ws + WS_MOD))[(size_t)(layer * NB + b) * NMOD + n0 + col] = s + p.in[5][(size_t)layer * NMOD + n0 + col]; }
            __syncthreads();
        } else {
            int t = task - N_GEMV; const float* src; bf16_t* dst; int Ks, Ns;
            if (t < 1024) { const int i = t >> 8; t &= 255; src = p.in[28] + (size_t)i * D * FF; dst = (bf16_t*)(ws + WS_W1T) + (size_t)i * D * FF; Ks = D; Ns = FF; }
            else if (t < 2048) { t -= 1024; const int i = t >> 8; t &= 255; src = p.in[29] + (size_t)i * D * FF; dst = (bf16_t*)(ws + WS_W2T) + (size_t)i * D * FF; Ks = FF; Ns = D; }
            else if (t < 2432) { t -= 2048; const int i = t / 192; t %= 192; src = p.in[6] + (size_t)i * D * 3 * D; dst = (bf16_t*)(ws + WS_WINT) + (size_t)i * D * 3 * D; Ks = D; Ns = 3 * D; }
            else { t -= 2432; const int mi = t >> 6; t &= 63; Ks = D; Ns = D;
                if (mi < 2) { src = p.in[8] + (size_t)mi * D * D; dst = (bf16_t*)(ws + WS_WOUTT) + (size_t)mi * D * D; }
                else if (mi < 8) { src = p.in[10] + (size_t)(mi - 2) * D * D; dst = (bf16_t*)(ws + WS_RKVT) + (size_t)(mi - 2) * D * D; }
                else { src = p.in[11] + (size_t)(mi - 8) * D * D; dst = (bf16_t*)(ws + WS_WOT) + (size_t)(mi - 8) * D * D; } }
            const int ntn = Ns >> 7, k0 = (t / ntn) * 128, n0 = (t % ntn) * 128;
#pragma unroll
            for (int it = 0; it < 8; ++it) { const int k = it * 16 + (tid >> 5), n = (tid & 31) * 4;
                const f32x4 v = *(const f32x4*)(src + (size_t)(k0 + k) * Ns + n0 + n);
                *(LAS f32x4*)(tile + k * 132 + n) = v; }
            __syncthreads();
#pragma unroll
            for (int it = 0; it < 4; ++it) { const int n = tid & 127, ko = (tid >> 7) + 4 * it;
                float v[8];
#pragma unroll
                for (int j = 0; j < 8; ++j) v[j] = tile[(ko * 8 + j) * 132 + n];
                u32x4 w; w.x = cvt_pk_bf16(v[0], v[1]); w.y = cvt_pk_bf16(v[2], v[3]); w.z = cvt_pk_bf16(v[4], v[5]); w.w = cvt_pk_bf16(v[6], v[7]);
                *(u32x4*)(dst + (size_t)(n0 + n) * Ks + k0 + ko * 8) = w; }
            __syncthreads();
        }
    }
    const size_t gtid = (size_t)blockIdx.x * NTHREADS + tid, gsz = (size_t)gridDim.x * NTHREADS;
    for (size_t e = gtid; e < (size_t)2 * 512 * 2048; e += gsz) {
        const int j = (int)(e >> 20), n = (int)((e >> 11) & 511), k = (int)(e & 2047), kk = k & 1023; const bool first = k < 1024;
        float w = 0.f; int mi = -1;
        if (n < 64) { w = p.in[13][(size_t)j * D * 64 + (size_t)kk * 64 + n]; mi = 1; }
        else if (n < 128) { w = p.in[16][(size_t)j * D * 64 + (size_t)kk * 64 + (n - 64)]; mi = 4; }
        else if (n < 288) { w = p.in[18][(size_t)j * D * 160 + (size_t)kk * 160 + (n - 128)]; mi = 5; }
        else if (n < 320 && j == 1) { w = p.in[26][(size_t)kk * 32 + (n - 288)]; mi = 3; }
        if (mi >= 0) { const float mu = p.in[9][(size_t)j * 6 * D + mi * D + kk]; w *= first ? mu : (1.0f - mu); }
        ((bf16_t*)(ws + WS_L1T))[e] = (bf16_t)(cvt_pk_bf16(w, 0.f) & 0xffffu);
    }
    for (size_t e = gtid; e < (size_t)2 * 4096 * 256; e += gsz) {
        const int j = (int)(e >> 20), n = (int)((e >> 8) & 4095), k = (int)(e & 255), grp = n >> 10, nn = n & 1023;
        float w = 0.f;
        if (grp == 0) { if (k < 64) w = p.in[14][(size_t)j * 64 * D + (size_t)k * D + nn]; }
        else if (grp == 1) { if (k >= 64 && k < 128) w = p.in[17][(size_t)j * 64 * D + (size_t)(k - 64) * D + nn]; }
        else if (grp == 2) { if (k < 160) w = p.in[19][(size_t)j * 160 * D + (size_t)k * D + nn]; }
        else { if (j == 1 && k >= 32 && k < 64) w = p.in[27][(size_t)(k - 32) * D + nn]; }
        ((bf16_t*)(ws + WS_L2T))[e] = (bf16_t)(cvt_pk_bf16(w, 0.f) & 0xffffu);
    }
}

template <int MODE>
__device__ __forceinline__ void norm_phase(const float* x, const float* g, const float* mod_sh, const float* mod_sc, bf16_t* HB,
                                           const float* mu, bf16_t* XR, bf16_t* XK, bf16_t* XV, float* ssq_out = nullptr) {
    const int tid_ = otid(), lane = tid_ & 63, gw = blockIdx.x * 8 + (tid_ >> 6), GW = gridDim.x * 8;
    constexpr int NT = (MODE == 1) ? 2 : 4;
    for (int tok0 = gw; tok0 < M; tok0 += NT * GW) {
        f32x4 xv[NT][4], xp[NT][4]; float ss[NT], sp[NT];
#pragma unroll
        for (int u = 0; u < NT; ++u) { ss[u] = 0.f; sp[u] = 0.f; }
#pragma unroll
        for (int u = 0; u < NT; ++u) { const int tok = tok0 + u * GW; const bool ok = tok < M; const int s = tok & (SEQ - 1);
#pragma unroll
            for (int j = 0; j < 4; ++j) { xv[u][j] = ok ? *(const f32x4*)(x + (size_t)tok * D + j * 256 + lane * 4) : (f32x4){0.f, 0.f, 0.f, 0.f};
                if (MODE == 1) xp[u][j] = (ok && s > 0) ? *(const f32x4*)(x + (size_t)(tok - 1) * D + j * 256 + lane * 4) : (f32x4){0.f, 0.f, 0.f, 0.f}; } }
#pragma unroll
        for (int u = 0; u < NT; ++u)
#pragma unroll
            for (int j = 0; j < 4; ++j) { ss[u] += xv[u][j][0] * xv[u][j][0] + xv[u][j][1] * xv[u][j][1] + xv[u][j][2] * xv[u][j][2] + xv[u][j][3] * xv[u][j][3];
                if (MODE == 1) sp[u] += xp[u][j][0] * xp[u][j][0] + xp[u][j][1] * xp[u][j][1] + xp[u][j][2] * xp[u][j][2] + xp[u][j][3] * xp[u][j][3]; }
#pragma unroll
        for (int u = 0; u < NT; ++u) { const int tok = tok0 + u * GW; if (tok >= M) break;
            const int b = tok >> 12, s = tok & (SEQ - 1);
            const float ssw = wave_sum(ss[u]);
            const float ri = (MODE == 2) ? 1.0f : rsqrtf(ssw * (1.0f / D) + 1e-6f);
            if (MODE == 2) { if (lane < 16) ssq_out[(size_t)tok * 16 + lane] = (lane == 0) ? ssw : 0.f; }
            float rp = 0.f; if (MODE == 1) rp = rsqrtf(wave_sum(sp[u]) * (1.0f / D) + 1e-6f);
            const size_t hrow = (size_t)(b * HROWS + PADROWS + s) * D;
#pragma unroll
            for (int j = 0; j < 4; ++j) { const int c = j * 256 + lane * 4;
                const f32x4 gv = *(const f32x4*)(g + c), shv = *(const f32x4*)(mod_sh + (size_t)b * NMOD + c), scv = *(const f32x4*)(mod_sc + (size_t)b * NMOD + c);
                const f32x4 h = (MODE == 2) ? xv[u][j] * gv * (1.0f + scv) : xv[u][j] * ri * gv * (1.0f + scv) + shv;
                st_bf4(HB + hrow + c, h);
                if (MODE == 1) {
                    f32x4 hp = xp[u][j] * rp * gv * (1.0f + scv) + shv; if (s == 0) hp = (f32x4){0.f, 0.f, 0.f, 0.f};
                    const f32x4 xx = hp - h;
                    const f32x4 mr = *(const f32x4*)(mu + c), mk = *(const f32x4*)(mu + 2 * D + c), mv = *(const f32x4*)(mu + 3 * D + c);
                    st_bf4(XR + (size_t)tok * D + c, h + xx * mr); st_bf4(XK + (size_t)tok * D + c, h + xx * mk); st_bf4(XV + (size_t)tok * D + c, h + xx * mv);
                    if (s == 0) *(u32x2*)(HB + hrow - D + c) = (u32x2){0u, 0u};
                } } }
    }
}

__device__ __forceinline__ void conv_phase(const bf16_t* BCH, const float* cw, bf16_t* Z) {
    const int tid_ = otid(), lane = tid_ & 63, gw = blockIdx.x * 8 + (tid_ >> 6), GW = gridDim.x * 8;
    for (int tok0 = gw; tok0 < M; tok0 += 2 * GW) {
        u32x2 rb[2][4], rc0[2][4], rh0[2][4], rc1[2][4], rh1[2][4], rc2[2][4], rh2[2][4];
#pragma unroll
        for (int u = 0; u < 2; ++u) { const int tok = tok0 + u * GW; const bool ok = tok < M; const int s = tok & (SEQ - 1);
#pragma unroll
            for (int j = 0; j < 4; ++j) { const bf16_t* rp = BCH + (size_t)tok * 3 * D + j * 256 + lane * 4; const u32x2 z2 = (u32x2){0u, 0u};
                rb[u][j] = ok ? *(const u32x2*)rp : z2; rc0[u][j] = ok ? *(const u32x2*)(rp + D) : z2; rh0[u][j] = ok ? *(const u32x2*)(rp + 2 * D) : z2;
                rc1[u][j] = (ok && s >= 1) ? *(const u32x2*)(rp - 2 * D) : z2; rh1[u][j] = (ok && s >= 1) ? *(const u32x2*)(rp - D) : z2;
                rc2[u][j] = (ok && s >= 2) ? *(const u32x2*)(rp - 5 * D) : z2; rh2[u][j] = (ok && s >= 2) ? *(const u32x2*)(rp - 4 * D) : z2; } }
#pragma unroll
        for (int u = 0; u < 2; ++u) { const int tok = tok0 + u * GW; if (tok >= M) break;
#pragma unroll
            for (int j = 0; j < 4; ++j) { const int c = j * 256 + lane * 4;
#define CV4(v) ((f32x4){bflo((v).x), bfhi((v).x), bflo((v).y), bfhi((v).y)})
                const f32x4 bg = CV4(rb[u][j]), u0 = CV4(rc0[u][j]) * CV4(rh0[u][j]), u1 = CV4(rc1[u][j]) * CV4(rh1[u][j]), u2 = CV4(rc2[u][j]) * CV4(rh2[u][j]);
#undef CV4
                const f32x4 w0 = *(const f32x4*)(cw + c), w1 = *(const f32x4*)(cw + D + c), w2 = *(const f32x4*)(cw + 2 * D + c);
                st_bf4(Z + (size_t)tok * D + c, bg * (w0 * u2 + w1 * u1 + w2 * u0)); } }
    }
}

namespace wk {
constexpr int MS = 72;
constexpr int MATB = 64 * MS * 2;
constexpr int CW_OFF = 11 * MATB;
constexpr int BT_OFF = 15 * MATB;
constexpr int WL_OFF = BT_OFF + 2048;
enum { AT = 0, RT = 1, BDT = 2, KDT = 3, VT = 4, MAKT = 5, MRBT = 6, MRKT = 7, SB = 8, BT_ = 9, KT_ = 10, PA = 11, PB = 12, TA = 13, TB = 14 };
__device__ __forceinline__ LAS bf16_t* mat(LAS unsigned char* lds, int i) { return (LAS bf16_t*)(lds + i * MATB); }
template <bool F16 = false>
__device__ __forceinline__ void mm2(f32x4 (&acc)[2], const LAS bf16_t* A, const LAS bf16_t* B, int mi, int ni0, int fr, int fq) {
#pragma unroll
    for (int ks = 0; ks < 2; ++ks) {
        const bf16x8 a = *(const LAS bf16x8*)(A + (mi * 16 + fr) * MS + ks * 32 + fq * 8);
#pragma unroll
        for (int n = 0; n < 2; ++n) { const bf16x8 b = *(const LAS bf16x8*)(B + ((ni0 + n) * 16 + fr) * MS + ks * 32 + fq * 8);
            if (F16) acc[n] = __builtin_amdgcn_mfma_f32_16x16x32_f16(__builtin_bit_cast(f16x8, a), __builtin_bit_cast(f16x8, b), acc[n], 0, 0, 0);
            else acc[n] = __builtin_amdgcn_mfma_f32_16x16x32_bf16(a, b, acc[n], 0, 0, 0); }
    }
}
__device__ __forceinline__ void st_rowmajor(LAS bf16_t* dst, const f32x4 c, int mi, int ni, int fr, int fq) {
    const unsigned lo = cvt_pk_bf16(c[0], c[1]), hi = cvt_pk_bf16(c[2], c[3]);
    LAS bf16_t* p = dst + (mi * 16 + fq * 4) * MS + ni * 16 + fr;
    p[0] = (bf16_t)(lo & 0xffffu); p[MS] = (bf16_t)(lo >> 16); p[2 * MS] = (bf16_t)(hi & 0xffffu); p[3 * MS] = (bf16_t)(hi >> 16);
}
__device__ __forceinline__ void st_rowmajor_h(LAS bf16_t* dst, const f32x4 c, int mi, int ni, int fr, int fq) {
    const unsigned lo = cvt_pk_f16(c[0], c[1]), hi = cvt_pk_f16(c[2], c[3]);
    LAS bf16_t* p = dst + (mi * 16 + fq * 4) * MS + ni * 16 + fr;
    p[0] = (bf16_t)(lo & 0xffffu); p[MS] = (bf16_t)(lo >> 16); p[2 * MS] = (bf16_t)(hi & 0xffffu); p[3 * MS] = (bf16_t)(hi >> 16);
}
__device__ __forceinline__ void st_transposed_h(LAS bf16_t* dst, const f32x4 c, int mi, int ni, int fr, int fq) {
    u32x2 w; w.x = cvt_pk_f16(c[0], c[1]); w.y = cvt_pk_f16(c[2], c[3]);
    *(LAS u32x2*)(dst + (ni * 16 + fr) * MS + mi * 16 + fq * 4) = w;
}
__device__ __forceinline__ void st_transposed(LAS bf16_t* dst, const f32x4 c, int mi, int ni, int fr, int fq) {
    u32x2 w; w.x = cvt_pk_bf16(c[0], c[1]); w.y = cvt_pk_bf16(c[2], c[3]);
    *(LAS u32x2*)(dst + (ni * 16 + fr) * MS + mi * 16 + fq * 4) = w;
}
}

__device__ __forceinline__ void wkv_chunk_phase(LAS unsigned char* lds, bf16_t* R, const bf16_t* KP, bf16_t* KK, bf16_t* BS, bf16_t* EW,
                                                const bf16_t* V, bf16_t* Y, float* WLG, const float* k_k, const float* k_a, const float* r_k, float* RK) {
    using namespace wk;
    const int tid = otid(), wid = __builtin_amdgcn_readfirstlane(tid >> 6), lane = tid & 63, fr = lane & 15, fq = lane >> 4;
    const int mi = wid >> 1, ni0 = (wid & 1) * 2;
    const int lt = tid >> 3, lk = (tid & 7) * 8;
    LAS float* CW = (LAS float*)(lds + CW_OFF); LAS float* BTOT = (LAS float*)(lds + BT_OFF);
    const f32x4 zero4 = (f32x4){0.f, 0.f, 0.f, 0.f};
    const int G = gridDim.x;
    int u = blockIdx.x;
    u32x4 g_ew, g_bs, g_kp, g_r, g_v; f32x4 g_c[6];
    g_ew = g_bs = g_kp = g_r = g_v = (u32x4){0u, 0u, 0u, 0u};
#pragma unroll
    for (int i = 0; i < 6; ++i) g_c[i] = (f32x4){0.f, 0.f, 0.f, 0.f};
    if (u < 4096) { const int head = u & 63, chunk = u >> 6; const size_t base = ((size_t)(head >> 4) * SEQ + chunk * 64 + lt) * D + (head & 15) * 64 + lk;
        g_ew = *(const u32x4*)(EW + base); g_bs = *(const u32x4*)(BS + base); g_kp = *(const u32x4*)(KP + base); g_r = *(const u32x4*)(R + base); g_v = *(const u32x4*)(V + base);
        const int co = (head & 15) * 64 + lk; g_c[0] = *(const f32x4*)(k_k + co); g_c[1] = *(const f32x4*)(k_k + co + 4); g_c[2] = *(const f32x4*)(k_a + co); g_c[3] = *(const f32x4*)(k_a + co + 4); g_c[4] = *(const f32x4*)(r_k + co); g_c[5] = *(const f32x4*)(r_k + co + 4); }
    for (; u < 4096; u += G) {
        const int head = u & 63, chunk = u >> 6, h = head & 15;
        const size_t tok0 = (size_t)(head >> 4) * SEQ + (size_t)chunk * 64;
        float ew[8];
        ew[0] = bflo(g_ew.x); ew[1] = bfhi(g_ew.x); ew[2] = bflo(g_ew.y); ew[3] = bfhi(g_ew.y); ew[4] = bflo(g_ew.z); ew[5] = bfhi(g_ew.z); ew[6] = bflo(g_ew.w); ew[7] = bfhi(g_ew.w);
        *(LAS f32x4*)(CW + lt * 64 + lk) = (f32x4){ew[0], ew[1], ew[2], ew[3]}; *(LAS f32x4*)(CW + lt * 64 + lk + 4) = (f32x4){ew[4], ew[5], ew[6], ew[7]};
        const u32x4 c_bs = g_bs, c_kp = g_kp, c_r = g_r, c_v = g_v;
        const f32x4 kka = g_c[0], kkb = g_c[1], kaa = g_c[2], kab = g_c[3], rka = g_c[4], rkb = g_c[5];
        if (u + G < 4096) { const int u2 = u + G, head2 = u2 & 63, chunk2 = u2 >> 6; const size_t nb = ((size_t)(head2 >> 4) * SEQ + chunk2 * 64 + lt) * D + (head2 & 15) * 64 + lk;
            g_ew = *(const u32x4*)(EW + nb); g_bs = *(const u32x4*)(BS + nb); g_kp = *(const u32x4*)(KP + nb); g_r = *(const u32x4*)(R + nb); g_v = *(const u32x4*)(V + nb);
            const int co = (head2 & 15) * 64 + lk; g_c[0] = *(const f32x4*)(k_k + co); g_c[1] = *(const f32x4*)(k_k + co + 4); g_c[2] = *(const f32x4*)(k_a + co); g_c[3] = *(const f32x4*)(k_a + co + 4); g_c[4] = *(const f32x4*)(r_k + co); g_c[5] = *(const f32x4*)(r_k + co + 4); }
        float kk[8], bs[8], kp[8], rr[8];
        { const float kr_[8] = {bflo(c_kp.x), bfhi(c_kp.x), bflo(c_kp.y), bfhi(c_kp.y), bflo(c_kp.z), bfhi(c_kp.z), bflo(c_kp.w), bfhi(c_kp.w)};
          const float aa[8] = {bflo(c_bs.x), bfhi(c_bs.x), bflo(c_bs.y), bfhi(c_bs.y), bflo(c_bs.z), bfhi(c_bs.z), bflo(c_bs.w), bfhi(c_bs.w)};
          const float r8[8] = {bflo(c_r.x), bfhi(c_r.x), bflo(c_r.y), bfhi(c_r.y), bflo(c_r.z), bfhi(c_r.z), bflo(c_r.w), bfhi(c_r.w)};
          const float ck[8] = {kka[0], kka[1], kka[2], kka[3], kkb[0], kkb[1], kkb[2], kkb[3]}, ca[8] = {kaa[0], kaa[1], kaa[2], kaa[3], kab[0], kab[1], kab[2], kab[3]}, cr[8] = {rka[0], rka[1], rka[2], rka[3], rkb[0], rkb[1], rkb[2], rkb[3]};
          float ss = 0.f, rk = 0.f;
#pragma unroll
          for (int j = 0; j < 8; ++j) { kk[j] = kr_[j] * ck[j]; ss += kk[j] * kk[j]; kp[j] = rbf(kr_[j] * (1.0f + (aa[j] - 1.0f) * ca[j])); rr[j] = r8[j]; rk += r8[j] * kp[j] * cr[j]; }
          ss += dppf<0xB1>(ss); ss += dppf<0x4E>(ss); ss += dppf<0x141>(ss);
          rk += dppf<0xB1>(rk); rk += dppf<0x4E>(rk); rk += dppf<0x141>(rk);
          const float inv = 1.0f / fmaxf(sqrtf(ss), 1e-12f);
#pragma unroll
          for (int j = 0; j < 8; ++j) { kk[j] = rbf(kk[j] * inv); bs[j] = rbf(kk[j] * aa[j]); }
          if ((tid & 7) == 0) RK[(tok0 + lt) * 16 + h] = rk; }
        __syncthreads();
        { const int k = tid & 63, blk = tid >> 6; float run = 0.f, pre[8];
#pragma unroll
          for (int j = 0; j < 8; ++j) { run += CW[(blk * 8 + j) * 64 + k]; pre[j] = run; }
          BTOT[blk * 64 + k] = run;
          __syncthreads();
          float off = 0.f;
#pragma unroll
          for (int bb = 0; bb < 7; ++bb) off += (bb < blk) ? BTOT[bb * 64 + k] : 0.f;
#pragma unroll
          for (int j = 0; j < 8; ++j) CW[(blk * 8 + j) * 64 + k] = off + pre[j];
        }
        __syncthreads();
        { const f32x4 cwa = *(const LAS f32x4*)(CW + lt * 64 + lk), cwb = *(const LAS f32x4*)(CW + lt * 64 + lk + 4);
          const f32x4 cla = *(const LAS f32x4*)(CW + 63 * 64 + lk), clb = *(const LAS f32x4*)(CW + 63 * 64 + lk + 4);
          float cw[8] = {cwa[0], cwa[1], cwa[2], cwa[3], cwb[0], cwb[1], cwb[2], cwb[3]}, cl[8] = {cla[0], cla[1], cla[2], cla[3], clb[0], clb[1], clb[2], clb[3]};
          float at_[8], rt_[8], bt_[8], kt_[8], bd_[8], kd_[8];
          if (lt == 63) { float* wp = WLG + ((size_t)head * 64 + chunk) * 64 + lk;
#pragma unroll
              for (int j = 0; j < 8; ++j) wp[j] = __expf(-cl[j]); }
#pragma unroll
          for (int j = 0; j < 8; ++j) { const float e1 = __expf(-cw[j]), e0 = __expf(ew[j] - cw[j]), ep = __expf(cw[j]), ed = __expf(cw[j] - cl[j]);
              at_[j] = -kk[j] * e0; rt_[j] = rr[j] * e1; bt_[j] = bs[j] * ep; kt_[j] = kp[j] * ep; bd_[j] = bs[j] * ed; kd_[j] = kp[j] * ed; }
#define PK8(a) ((u32x4){cvt_pk_bf16(a[0], a[1]), cvt_pk_bf16(a[2], a[3]), cvt_pk_bf16(a[4], a[5]), cvt_pk_bf16(a[6], a[7])})
          const u32x4 pat = PK8(at_), pbd = PK8(bd_), pkd = PK8(kd_);
          *(LAS u32x4*)(mat(lds, AT) + lt * MS + lk) = pat; *(LAS u32x4*)(mat(lds, RT) + lt * MS + lk) = PK8(rt_);
          *(LAS u32x4*)(mat(lds, BT_) + lt * MS + lk) = PK8(bt_); *(LAS u32x4*)(mat(lds, KT_) + lt * MS + lk) = PK8(kt_);
#undef PK8
#define TR8(dstm, VAL_) do { const u32x4 v_ = (VAL_); LAS bf16_t* q_ = mat(lds, dstm) + lk * MS + lt; q_[0] = (bf16_t)(v_.x & 0xffffu); q_[MS] = (bf16_t)(v_.x >> 16); q_[2 * MS] = (bf16_t)(v_.y & 0xffffu); q_[3 * MS] = (bf16_t)(v_.y >> 16); \
              q_[4 * MS] = (bf16_t)(v_.z & 0xffffu); q_[5 * MS] = (bf16_t)(v_.z >> 16); q_[6 * MS] = (bf16_t)(v_.w & 0xffffu); q_[7 * MS] = (bf16_t)(v_.w >> 16); } while (0)
          TR8(BDT, pbd); TR8(KDT, pkd); TR8(VT, c_v); TR8(SB, ((u32x4){cvt_pk_f16(at_[0], at_[1]), cvt_pk_f16(at_[2], at_[3]), cvt_pk_f16(at_[4], at_[5]), cvt_pk_f16(at_[6], at_[7])}));
#undef TR8
        }
        __syncthreads();
        f32x4 Treg[2];
        { f32x4 gab[2] = {zero4, zero4}, gak[2] = {zero4, zero4}, grb[2] = {zero4, zero4}, grk[2] = {zero4, zero4};
          mm2(gab, mat(lds, BT_), mat(lds, AT), mi, ni0, fr, fq); mm2(gak, mat(lds, KT_), mat(lds, AT), mi, ni0, fr, fq);
          mm2(grb, mat(lds, BT_), mat(lds, RT), mi, ni0, fr, fq); mm2(grk, mat(lds, KT_), mat(lds, RT), mi, ni0, fr, fq);
#pragma unroll
          for (int n = 0; n < 2; ++n) { const int t = (ni0 + n) * 16 + fr;
#pragma unroll
              for (int j = 0; j < 4; ++j) { const int i = mi * 16 + fq * 4 + j;
                  gab[n][j] = (i < t) ? gab[n][j] : 0.f; gak[n][j] = (i < t) ? gak[n][j] : 0.f; grb[n][j] = (i <= t) ? grb[n][j] : 0.f; grk[n][j] = (i <= t) ? grk[n][j] : 0.f;
                  Treg[n][j] = gab[n][j] + ((i == t) ? 1.f : 0.f); } }
#pragma unroll
          for (int n = 0; n < 2; ++n) { const int ni = ni0 + n;
              st_rowmajor_h(mat(lds, PA), gab[n], mi, ni, fr, fq); st_transposed_h(mat(lds, PB), gab[n], mi, ni, fr, fq); st_rowmajor_h(mat(lds, TA), Treg[n], mi, ni, fr, fq);
              st_transposed(mat(lds, MAKT), gak[n], mi, ni, fr, fq); st_transposed(mat(lds, MRBT), grb[n], mi, ni, fr, fq); st_transposed(mat(lds, MRKT), grk[n], mi, ni, fr, fq); }
        }
        __syncthreads();
#pragma unroll
        for (int st = 1; st <= 6; ++st) {
            LAS bf16_t* Pa = mat(lds, ((st - 1) & 1) ? BT_ : PA); LAS bf16_t* Pb = mat(lds, ((st - 1) & 1) ? KT_ : PB);
            if (st <= 5) { LAS bf16_t* Na = mat(lds, (st & 1) ? BT_ : PA); LAS bf16_t* Nb = mat(lds, (st & 1) ? KT_ : PB);
                f32x4 pw[2] = {zero4, zero4};
                mm2<true>(pw, Pa, Pb, mi, ni0, fr, fq);
                st_rowmajor_h(Na, pw[0], mi, ni0, fr, fq); st_rowmajor_h(Na, pw[1], mi, ni0 + 1, fr, fq);
                st_transposed_h(Nb, pw[0], mi, ni0, fr, fq); st_transposed_h(Nb, pw[1], mi, ni0 + 1, fr, fq); }
            if (st >= 2) { LAS bf16_t* Tp = mat(lds, ((st - 2) & 1) ? TB : TA);
                mm2<true>(Treg, Tp, Pb, mi, ni0, fr, fq);
                if (st < 6) { LAS bf16_t* Tn = mat(lds, ((st - 1) & 1) ? TB : TA); st_rowmajor_h(Tn, Treg[0], mi, ni0, fr, fq); st_rowmajor_h(Tn, Treg[1], mi, ni0 + 1, fr, fq); }
                else { st_transposed_h(mat(lds, TB), Treg[0], mi, ni0, fr, fq); st_transposed_h(mat(lds, TB), Treg[1], mi, ni0 + 1, fr, fq); } }
            __syncthreads();
        }
        { f32x4 a2[2] = {zero4, zero4}, x1[2] = {zero4, zero4};
          mm2<true>(a2, mat(lds, SB), mat(lds, TB), mi, ni0, fr, fq); mm2(x1, mat(lds, VT), mat(lds, MAKT), mi, ni0, fr, fq);
          st_rowmajor(mat(lds, PA), a2[0], mi, ni0, fr, fq); st_rowmajor(mat(lds, PA), a2[1], mi, ni0 + 1, fr, fq);
          st_rowmajor_h(mat(lds, PB), x1[0], mi, ni0, fr, fq); st_rowmajor_h(mat(lds, PB), x1[1], mi, ni0 + 1, fr, fq); }
        __syncthreads();
        { f32x4 xp[2] = {zero4, zero4}, r2[2], pl[2] = {zero4, zero4};
#pragma unroll
          for (int n = 0; n < 2; ++n) { const u32x2 w = *(const LAS u32x2*)(mat(lds, RT) + ((ni0 + n) * 16 + fr) * MS + mi * 16 + fq * 4); r2[n] = (f32x4){bflo(w.x), bfhi(w.x), bflo(w.y), bfhi(w.y)}; }
          mm2<true>(xp, mat(lds, PB), mat(lds, TB), mi, ni0, fr, fq); mm2(r2, mat(lds, PA), mat(lds, MRBT), mi, ni0, fr, fq); mm2(pl, mat(lds, PA), mat(lds, BDT), mi, ni0, fr, fq);
          st_rowmajor(mat(lds, BT_), xp[0], mi, ni0, fr, fq); st_rowmajor(mat(lds, BT_), xp[1], mi, ni0 + 1, fr, fq);
#pragma unroll
          for (int n = 0; n < 2; ++n) { const size_t o = (tok0 + (ni0 + n) * 16 + fr) * D + h * 64 + mi * 16 + fq * 4; st_h4(BS + o, r2[n]); st_h4(EW + o, pl[n]); } }
        __syncthreads();
        { f32x4 y0[2] = {zero4, zero4}, qq[2] = {zero4, zero4};
          mm2(y0, mat(lds, BT_), mat(lds, MRBT), mi, ni0, fr, fq); mm2(y0, mat(lds, VT), mat(lds, MRKT), mi, ni0, fr, fq);
          mm2(qq, mat(lds, BT_), mat(lds, BDT), mi, ni0, fr, fq); mm2(qq, mat(lds, VT), mat(lds, KDT), mi, ni0, fr, fq);
#pragma unroll
          for (int n = 0; n < 2; ++n) { const size_t o = (tok0 + (ni0 + n) * 16 + fr) * D + h * 64 + mi * 16 + fq * 4;
              st_h4(Y + o, y0[n]);
              st_h4(KK + o, qq[n]); } }
        __syncthreads();
    }
}

__device__ __forceinline__ void wkv_state_phase(LAS unsigned char* lds, const bf16_t* PLT, const bf16_t* QT, const float* WLG, bf16_t* SC) {
    using namespace wk;
    constexpr int PF = 8;
    const int tid = otid(), wid = __builtin_amdgcn_readfirstlane(tid >> 6), lane = tid & 63, fr = lane & 15, fq = lane >> 4;
    const bool act = wid < 4; const int ni = wid & 3;
    for (int unit = blockIdx.x; unit < 256; unit += gridDim.x) {
        const int head = unit >> 2, qv = unit & 3, b = head >> 4, h = head & 15;
        f32x4 S = (f32x4){0.f, 0.f, 0.f, 0.f};
        u32x4 rb0[PF], rb1[PF]; u32x2 rq[PF]; float rw[PF];
        const int lrow = act ? ni * 16 + fr : 0, lfq = act ? fq : 0;
        const size_t obase = ((size_t)b * SEQ + lrow) * D + h * 64;
        const float* wbase = WLG + ((size_t)head * 64) * 64 + lrow;
#pragma unroll
        for (int i = 0; i < PF; ++i) { rb0[i] = rb1[i] = (u32x4){0u, 0u, 0u, 0u}; rq[i] = (u32x2){0u, 0u}; rw[i] = 0.f;
            { const size_t o = obase + (size_t)i * 64 * D; rb0[i] = *(const u32x4*)(PLT + o + lfq * 8); rb1[i] = *(const u32x4*)(PLT + o + 32 + lfq * 8); rq[i] = *(const u32x2*)(QT + o + qv * 16 + lfq * 4); rw[i] = wbase[i * 64]; } }
#define SB_STEP(i) do { \
                const int c = c0 + (i); \
                const size_t tok0 = (size_t)b * SEQ + (size_t)c * 64; \
                LAS bf16_t* buf = (LAS bf16_t*)(lds + ((i) & 1) * 16 * MS * 2); \
                const u32x4 b0 = rb0[i], b1 = rb1[i]; const u32x2 cq = rq[i]; const float wl = rw[i]; \
                if (act) { const unsigned lo = cvt_pk_f16(S[0], S[1]), hi = cvt_pk_f16(S[2], S[3]); LAS bf16_t* p = buf + (fq * 4) * MS + ni * 16 + fr; \
                    p[0] = (bf16_t)(lo & 0xffffu); p[MS] = (bf16_t)(lo >> 16); p[2 * MS] = (bf16_t)(hi & 0xffffu); p[3 * MS] = (bf16_t)(hi >> 16); } \
                    { const int cn = (c + PF < 64) ? c + PF : 63; const size_t o = obase + (size_t)cn * 64 * D;        \
                        rb0[i] = *(const u32x4*)(PLT + o + lfq * 8); rb1[i] = *(const u32x4*)(PLT + o + 32 + lfq * 8); rq[i] = *(const u32x2*)(QT + o + qv * 16 + lfq * 4); rw[i] = wbase[cn * 64]; } \
                __syncthreads(); \
                if (tid >= 256 && tid < 384) { const int row = (tid >> 3) & 15, pc = tid & 7; \
                    *(u32x4*)(SC + (tok0 + qv * 16 + row) * D + h * 64 + pc * 8) = *(const LAS u32x4*)(buf + row * MS + pc * 8); } \
                if (act) { const bf16x8 a0 = *(const LAS bf16x8*)(buf + fr * MS + fq * 8), a1 = *(const LAS bf16x8*)(buf + fr * MS + 32 + fq * 8); \
                    const f32x2 q01 = unpk_f16(cq.x), q23 = unpk_f16(cq.y); \
                    f32x4 acc = S * wl + (f32x4){q01.x, q01.y, q23.x, q23.y}; \
                    acc = __builtin_amdgcn_mfma_f32_16x16x32_f16(__builtin_bit_cast(f16x8, a0), __builtin_bit_cast(f16x8, b0), acc, 0, 0, 0); \
                    acc = __builtin_amdgcn_mfma_f32_16x16x32_f16(__builtin_bit_cast(f16x8, a1), __builtin_bit_cast(f16x8, b1), acc, 0, 0, 0); \
                    S = acc; } } while (0)
#define SB_STEP8(c0_) do { const int c0 = (c0_); SB_STEP(0); SB_STEP(1); SB_STEP(2); SB_STEP(3); SB_STEP(4); SB_STEP(5); SB_STEP(6); SB_STEP(7); } while (0)
        SB_STEP8(0); SB_STEP8(8); SB_STEP8(16); SB_STEP8(24); SB_STEP8(32); SB_STEP8(40); SB_STEP8(48); SB_STEP8(56);
#undef SB_STEP8
#undef SB_STEP
        __syncthreads();
    }
}

__device__ __forceinline__ void wkv_out_phase(const bf16_t* SC, const bf16_t* R2T, const bf16_t* Y0L, bf16_t* Y,
                                              const bf16_t* V, const bf16_t* Gt, const float* RK, const float* ln_w, const float* ln_b) {
    const int tid = otid(), wid = __builtin_amdgcn_readfirstlane(tid >> 6), lane = tid & 63, fr = lane & 15, fq = lane >> 4;
    const int ni = wid & 3, grp = wid >> 2;
    const int G = gridDim.x;
    for (int u = blockIdx.x + grp * G; u < 4096; u += 2 * G) {
        const int head = u & 63, chunk = u >> 6, h = head & 15;
        const size_t tok0 = (size_t)(head >> 4) * SEQ + (size_t)chunk * 64;
        const size_t trow = (tok0 + ni * 16 + fr) * D + h * 64;
        const bf16x8 b0 = *(const bf16x8*)(R2T + trow + fq * 8), b1 = *(const bf16x8*)(R2T + trow + 32 + fq * 8);
        bf16x8 a0[4], a1[4]; f32x4 acc[4]; u32x2 vv[4], gg[4]; f32x4 lw[4], lb[4];
#pragma unroll
        for (int mi = 0; mi < 4; ++mi) { const bf16_t* ap = SC + (tok0 + mi * 16 + fr) * D + h * 64 + fq * 8;
            a0[mi] = *(const bf16x8*)ap; a1[mi] = *(const bf16x8*)(ap + 32);
            const size_t o = trow + mi * 16 + fq * 4;
            acc[mi] = ld_h4(Y + o);
            vv[mi] = *(const u32x2*)(V + o); gg[mi] = *(const u32x2*)(Gt + o);
            lw[mi] = *(const f32x4*)(ln_w + h * 64 + mi * 16 + fq * 4); lb[mi] = *(const f32x4*)(ln_b + h * 64 + mi * 16 + fq * 4); }
        const float rk = RK[(tok0 + ni * 16 + fr) * 16 + h];
        float s1 = 0.f, s2 = 0.f;
#pragma unroll
        for (int mi = 0; mi < 4; ++mi) {
            acc[mi] = __builtin_amdgcn_mfma_f32_16x16x32_f16(__builtin_bit_cast(f16x8, a0[mi]), __builtin_bit_cast(f16x8, b0), acc[mi], 0, 0, 0);
            acc[mi] = __builtin_amdgcn_mfma_f32_16x16x32_f16(__builtin_bit_cast(f16x8, a1[mi]), __builtin_bit_cast(f16x8, b1), acc[mi], 0, 0, 0); }
#pragma unroll
        for (int mi = 0; mi < 4; ++mi) { const f32x4 y = acc[mi]; s1 += (y[0] + y[1]) + (y[2] + y[3]); }
        s1 += __shfl_xor(s1, 16); s1 += __shfl_xor(s1, 32);
        const float mean = s1 * (1.0f / 64.0f);
#pragma unroll
        for (int mi = 0; mi < 4; ++mi) { const f32x4 d = acc[mi] - mean; s2 += (d[0] * d[0] + d[1] * d[1]) + (d[2] * d[2] + d[3] * d[3]); }
        s2 += __shfl_xor(s2, 16); s2 += __shfl_xor(s2, 32);
        const float rs = rsqrtf(s2 * (1.0f / 64.0f) + 64e-5f);
#pragma unroll
        for (int mi = 0; mi < 4; ++mi) {
            const f32x4 v4 = (f32x4){bflo(vv[mi].x), bfhi(vv[mi].x), bflo(vv[mi].y), bfhi(vv[mi].y)}, g4 = (f32x4){bflo(gg[mi].x), bfhi(gg[mi].x), bflo(gg[mi].y), bfhi(gg[mi].y)};
            st_bf4(Y + trow + mi * 16 + fq * 4, ((acc[mi] - mean) * rs * lw[mi] + lb[mi] + rk * v4) * g4); }
    }
}

__device__ __forceinline__ void final_phase(float* x, const float* g) {
    const int tid_ = otid(), lane = tid_ & 63, gw = blockIdx.x * 8 + (tid_ >> 6), GW = gridDim.x * 8;
    for (int tok0 = gw; tok0 < M; tok0 += 4 * GW) {
        f32x4 xv[4][4]; float ss[4] = {0.f, 0.f, 0.f, 0.f};
#pragma unroll
        for (int u = 0; u < 4; ++u) { const int tok = tok0 + u * GW; const bool ok = tok < M;
#pragma unroll
            for (int j = 0; j < 4; ++j) { xv[u][j] = ok ? *(const f32x4*)(x + (size_t)tok * D + j * 256 + lane * 4) : (f32x4){0.f, 0.f, 0.f, 0.f};
                ss[u] += xv[u][j][0] * xv[u][j][0] + xv[u][j][1] * xv[u][j][1] + xv[u][j][2] * xv[u][j][2] + xv[u][j][3] * xv[u][j][3]; } }
#pragma unroll
        for (int u = 0; u < 4; ++u) { const int tok = tok0 + u * GW; if (tok >= M) break;
            const float ri = rsqrtf(wave_sum(ss[u]) * (1.0f / D) + 1e-6f);
#pragma unroll
            for (int j = 0; j < 4; ++j) { const int c = j * 256 + lane * 4; *(f32x4*)(x + (size_t)tok * D + c) = xv[u][j] * ri * *(const f32x4*)(g + c); } }
    }
}

__device__ __forceinline__ void e0_phase(const Params& p) {
    unsigned char* ws = p.ws;
    const int tid_ = otid(), lane = tid_ & 63, gw = blockIdx.x * 8 + (tid_ >> 6), GW = gridDim.x * 8;
    const float* MOD = (const float*)(ws + WS_MOD);
    float* GG = (float*)(ws + WS_GG);
    for (int e = blockIdx.x * NTHREADS + tid_; e < 4 * 2 * NB * D; e += gridDim.x * NTHREADS) {
        const int c = e & (D - 1), b = (e >> 10) & 3, sub = (e >> 12) & 1, layer = e >> 13;
        GG[e] = p.in[2][(size_t)(layer * 2 + sub) * D + c] * (1.0f + MOD[(size_t)(layer * NB + b) * NMOD + (sub ? 4 * D : D) + c]);
    }
    for (int task = gw; task < 4 * FF + 2 * 3 * D; task += GW) {
        const bf16_t* wrow; const float* sh; float* outp; int ostride;
        if (task < 4 * FF) { const int layer = task >> 12, n = task & (FF - 1);
            wrow = (const bf16_t*)(ws + WS_W1T) + ((size_t)layer * FF + n) * D; sh = MOD + (size_t)layer * NB * NMOD + 3 * D; outp = (float*)(ws + WS_SHW1) + (size_t)layer * NB * FF + n; ostride = FF; }
        else { const int t = task - 4 * FF, j = t / (3 * D), n = t % (3 * D);
            wrow = (const bf16_t*)(ws + WS_WINT) + ((size_t)j * 3 * D + n) * D; sh = MOD + (size_t)(2 * j) * NB * NMOD; outp = (float*)(ws + WS_SHWIN) + (size_t)j * NB * 3 * D + n; ostride = 3 * D; }
        float a0 = 0.f, a1 = 0.f, a2 = 0.f, a3 = 0.f;
#pragma unroll
        for (int jj = 0; jj < 4; ++jj) { const int c = jj * 256 + lane * 4; const f32x4 w = ld_bf4(wrow + c);
            const f32x4 s0 = *(const f32x4*)(sh + c), s1 = *(const f32x4*)(sh + NMOD + c), s2 = *(const f32x4*)(sh + 2 * NMOD + c), s3 = *(const f32x4*)(sh + 3 * NMOD + c);
            a0 += w[0] * s0[0] + w[1] * s0[1] + w[2] * s0[2] + w[3] * s0[3]; a1 += w[0] * s1[0] + w[1] * s1[1] + w[2] * s1[2] + w[3] * s1[3];
            a2 += w[0] * s2[0] + w[1] * s2[1] + w[2] * s2[2] + w[3] * s2[3]; a3 += w[0] * s3[0] + w[1] * s3[1] + w[2] * s3[2] + w[3] * s3[3]; }
        a0 = wave_sum(a0); a1 = wave_sum(a1); a2 = wave_sum(a2); a3 = wave_sum(a3);
        if (lane == 0) { outp[0] = a0; outp[ostride] = a1; outp[2 * ostride] = a2; outp[3 * ostride] = a3; }
    }
}

__global__ void __launch_bounds__(NTHREADS, 2) mega_fwd(Params p) {
    extern __shared__ __attribute__((aligned(16))) unsigned char lds_raw[];
    LAS unsigned char* lds = (LAS unsigned char*)lds_raw;
    cg::grid_group grid = cg::this_grid();
    unsigned char* ws = p.ws;
    const int G = gridDim.x, cid = blockIdx.x;
    float* X = p.out;
    const float* MOD = (const float*)(ws + WS_MOD);
    bf16_t* HB = (bf16_t*)(ws + WS_HB);
    unsigned char* R0 = ws + WS_R0;
    const char* HB_A = (const char*)(ws + WS_HB) + (size_t)PADROWS * D * 2;
    const char* HB_A2 = (const char*)(ws + WS_HB) + (size_t)(PADROWS - 1) * D * 2;

    if (blockIdx.x == 0) { unsigned* bw = (unsigned*)(ws + WS_BAR); for (int i = threadIdx.x; i < XCD_BAR_WORDS; i += NTHREADS) bw[i] = 0u; }
    if (threadIdx.x < 4) ((LAS unsigned*)(lds + LDS_BAR_OFF))[threadIdx.x] = 0u;
    p0_prologue(p, lds);
    grid.sync();
    const XcdBarrier xbar = xcd_barrier_post((unsigned*)(ws + WS_BAR), (volatile LAS unsigned*)(lds + LDS_BAR_OFF));
#define GSYNC() xcd_barrier(xbar)
    float* SSQ = (float*)(ws + WS_SS);
    const float* GG = (const float*)(ws + WS_GG);
    LAS float* RINV = (LAS float*)(lds + LDS_RINV_OFF);

    for (int layer = 0; layer < 4; ++layer) {
        const int j = layer >> 1;
        const float* xin = (layer == 0) ? p.in[0] : X;
        const float* mod = MOD + (size_t)layer * NB * NMOD;
        const bf16_t* mixA; const char* mixW;
        if ((layer & 1) == 0) {
            if (layer == 0) {
                e0_phase(p);
                norm_phase<2>(xin, p.in[2], mod, mod + D, HB, nullptr, nullptr, nullptr, nullptr, SSQ);
                GSYNC();
            }
            bf16_t* BCH = (bf16_t*)R0; bf16_t* Z = (bf16_t*)(R0 + 96 * MBy);
            { pg8::Gemm g{HB_A, (const char*)(ws + WS_WINT) + (size_t)j * 3 * D * D * 2, 64, 12, D, D, 1, 1 << 20, 0, 0, 0};
              pg8::StaticOrder S; S.init(64, 12, G, cid);
              pg8::EpiBf16<0, true> E{BCH, BCH, BCH, 3 * D, 0, SSQ, (const float*)(ws + WS_SHWIN) + (size_t)j * NB * 3 * D, 3 * D, RINV};
              pg8::gemm_phase(lds, g, S, E); }
            GSYNC();
            conv_phase(BCH, p.in[7] + (size_t)j * 3 * D, Z);
            GSYNC();
            mixA = Z; mixW = (const char*)(ws + WS_WOUTT) + (size_t)j * D * D * 2;
        } else {
            bf16_t* XR = (bf16_t*)R0; bf16_t* XK = (bf16_t*)(R0 + 32 * MBy); bf16_t* XV = (bf16_t*)(R0 + 64 * MBy);
            bf16_t* RB = (bf16_t*)(R0 + 96 * MBy); bf16_t* KB = (bf16_t*)(R0 + 128 * MBy);
            bf16_t* VF = (bf16_t*)(ws + WS_VF);
            bf16_t* VB = (j == 0) ? VF : (bf16_t*)(R0 + 160 * MBy);
            bf16_t* YB = (j == 0) ? (bf16_t*)(R0 + 160 * MBy) : VF;
            bf16_t* EW = XR; bf16_t* AB = XK; bf16_t* KK = XV; bf16_t* GB = HB;
            bf16_t* MIDS = (bf16_t*)(ws + WS_MIDS);
            float* BR = (float*)(ws + WS_BR); float* RKs = (float*)(ws + WS_RK);
            norm_phase<1>(xin, p.in[2] + (size_t)(layer * 2) * D, mod, mod + D, HB, p.in[9] + (size_t)j * 6 * D, XR, XK, XV);
            GSYNC();
            { pg8::Gemm g{(const char*)XR, (const char*)(ws + WS_RKVT) + (size_t)j * 3 * D * D * 2, 64, 12, D, D, 0, 4, 32 * MBy, 64 * MBy, 0};
              pg8::StaticOrder S; S.init(64, 12, G, cid); S.skew = (G == 256) ? 1 : 0;
              pg8::EpiBf16<0> E{RB, KB, VB, D, 4, nullptr, nullptr, 0, RINV};
              pg8::gemm_phase(lds, g, S, E); }
            { pg8::Gemm g{HB_A2, (const char*)(ws + WS_L1T) + (size_t)j * 512 * 2048 * 2, 64, 2, 2048, D, 1, 1 << 20, 0, 0, 0};
              pg8::StaticOrder S; S.init(64, 2, G, cid);
              pg8::EpiBf16<2> E{MIDS, MIDS, MIDS, 512, 0, nullptr, nullptr, 0, RINV};
              pg8::gemm_phase(lds, g, S, E); }
            GSYNC();
            { const int nN = (j == 0) ? 12 : 16;
              pg8::Gemm g{(const char*)MIDS, (const char*)(ws + WS_L2T) + (size_t)j * 4096 * 256 * 2, 64, nN, 256, 512, 0, 4, 0, 128 * 2, 256 * 2};
              pg8::StaticOrder S; S.init(64, nN, G, cid);
              pg8::EpiLora2 E{EW, AB, GB, VB, VF, p.in[12] + (size_t)j * D, p.in[15] + (size_t)j * D, p.in[25]};
              pg8::gemm_phase(lds, g, S, E); }
            GSYNC();
            wkv_chunk_phase(lds, RB, KB, KK, AB, EW, VB, YB, BR, p.in[20] + (size_t)j * D, p.in[21] + (size_t)j * D, p.in[22] + (size_t)j * D, RKs);
            GSYNC();
            wkv_state_phase(lds, EW, KK, BR, KB);
            GSYNC();
            wkv_out_phase(KB, AB, RB, YB, VB, GB, RKs, p.in[23] + (size_t)j * D, p.in[24] + (size_t)j * D);
            GSYNC();
            mixA = YB; mixW = (const char*)(ws + WS_WOT) + (size_t)j * D * D * 2;
        }
        { pg8::Gemm g{(const char*)mixA, mixW, 64, 4, D, D, 0, 1 << 20, 0, 0, 0};
          pg8::StaticOrder S; S.init(64, 4, G, cid);
          pg8::EpiResid E{xin, X, mod + 2 * D, 1, HB, GG + (size_t)(layer * 2 + 1) * NB * D, SSQ};
          pg8::gemm_phase(lds, g, S, E); }
        GSYNC();
        bf16_t* HID = (bf16_t*)R0;
        { pg8::Gemm g{HB_A, (const char*)(ws + WS_W1T) + (size_t)layer * D * FF * 2, 64, 16, D, D, 1, 1 << 20, 0, 0, 0};
          pg8::StaticOrder S; S.init(64, 16, G, cid);
          pg8::EpiBf16<1, true> E{HID, HID, HID, FF, 0, SSQ, (const float*)(ws + WS_SHW1) + (size_t)layer * NB * FF, FF, RINV};
          pg8::gemm_phase(lds, g, S, E); }
        GSYNC();
        { pg8::Gemm g{(const char*)HID, (const char*)(ws + WS_W2T) + (size_t)layer * D * FF * 2, 64, 4, FF, FF, 0, 1 << 20, 0, 0, 0};
          pg8::StaticOrder S; S.init(64, 4, G, cid);
          const int emit2 = (layer == 1) ? 1 : 0;
          pg8::EpiResid E{X, X, mod + 5 * D, emit2, HB, GG + (size_t)((layer + 1) * 2 % 8) * NB * D, SSQ};
          pg8::gemm_phase(lds, g, S, E); }
        GSYNC();
    }
    final_phase(X, p.in[3]);
}

extern "C" void kernel_launch(void* const* d_in, const int* in_sizes, int n_in, void* d_out, int out_size, void* d_ws, size_t ws_size, hipStream_t stream) {
    static int grid = 0;
    if (grid == 0) {
        if (n_in != 30 || out_size != M * D || ws_size < WS_END) { fprintf(stderr, "kernel_launch: unexpected shapes (n_in %d out %d ws %zu)\n", n_in, out_size, ws_size); grid = -1; return; }
        int dev = 0, cus = 0, per_cu = 0;
        (void)hipGetDevice(&dev);
        (void)hipDeviceGetAttribute(&cus, hipDeviceAttributeMultiprocessorCount, dev);
        if (hipFuncSetAttribute((const void*)mega_fwd, hipFuncAttributeMaxDynamicSharedMemorySize, LDS_BYTES) != hipSuccess) { fprintf(stderr, "kernel_launch: hipFuncSetAttribute failed\n"); grid = -1; return; }
        if (hipOccupancyMaxActiveBlocksPerMultiprocessor(&per_cu, (const void*)mega_fwd, NTHREADS, LDS_BYTES) != hipSuccess || per_cu < 1) { fprintf(stderr, "kernel_launch: occupancy query failed (%d)\n", per_cu); grid = -1; return; }
        grid = cus;
    }
    if (grid < 0) return;
    Params p{};
    for (int i = 0; i < 30; ++i) p.in[i] = (const float*)d_in[i];
    p.out = (float*)d_out; p.ws = (unsigned char*)d_ws;
    void* args[] = {&p};
    hipError_t e = hipLaunchCooperativeKernel((const void*)mega_fwd, dim3(grid), dim3(NTHREADS), args, LDS_BYTES, stream);
    if (e != hipSuccess) fprintf(stderr, "cooperative launch failed: %s (grid %d)\n", hipGetErrorString(e), grid);
}
```
